# Optimizing an MI355X kernel written in HIP

```python
import jax, jax.numpy as jnp
from jax import lax
import numpy as np

D_MODEL = 1024
BATCH = 16
SEQ = 4096
DEPTH = 1
DEC_BATCH = 1
DEC_SEQ = 16384
PAST_LEN = 128

GRID_W = 64
MLA_HEADS = 8
QK_NOPE = 64
QK_ROPE = 32
V_HEAD = 64
Q_LORA = 768
KV_LORA = 256
ROPE_BASE = 10000.0
Q_BLOCK = 128
NA_HEADS = 8
NA_HD = 64
NA_WIN_R = 8
NA_WIN_C = 16
D_FF = 2816
CONV_W = 3
EPS = 1e-6

MLA_W = MLA_HEADS * V_HEAD
NA_W = NA_HEADS * NA_HD
SPLITS = (Q_LORA, KV_LORA, QK_ROPE, NA_W, NA_W, NA_W, 2 * D_MODEL)
IN_COLS = sum(SPLITS)

kernel_name = 'hybrid_mla_natten_convffn_encoder'


def rmsnorm(x, g):
    xf = x.astype(jnp.float32)
    y = xf * lax.rsqrt(jnp.mean(xf * xf, axis=-1, keepdims=True) + EPS)
    return (y * g.astype(jnp.float32)).astype(x.dtype)


def rope_tables(S):
    inv = ROPE_BASE ** (-jnp.arange(0, QK_ROPE, 2, dtype=jnp.float32) / QK_ROPE)
    ang = jnp.arange(S, dtype=jnp.float32)[:, None] * inv[None, :]
    return jnp.cos(ang), jnp.sin(ang)


def rotary(x, cos, sin):
    x1, x2 = jnp.split(x, 2, axis=-1)
    c = cos[None, :, None, :].astype(x.dtype)
    s = sin[None, :, None, :].astype(x.dtype)
    return jnp.concatenate([x1 * c - x2 * s, x1 * s + x2 * c], axis=-1)


def mla_branch(c_q, c_kv, k_pe, g_q, w_qb, g_kv, w_kvb):
    B, S, _ = c_q.shape
    q = (rmsnorm(c_q, g_q) @ w_qb).reshape(B, S, MLA_HEADS, QK_NOPE + QK_ROPE)
    q_nope, q_pe = q[..., :QK_NOPE], q[..., QK_NOPE:]
    kv = (rmsnorm(c_kv, g_kv) @ w_kvb).reshape(B, S, MLA_HEADS, QK_NOPE + V_HEAD)
    k_nope, v = kv[..., :QK_NOPE], kv[..., QK_NOPE:]
    cos, sin = rope_tables(S)
    q_pe = rotary(q_pe, cos, sin)
    k_pe = rotary(k_pe[:, :, None, :], cos, sin)[:, :, 0, :]
    scale = (QK_NOPE + QK_ROPE) ** -0.5
    n_blk = S // Q_BLOCK
    qn_b = q_nope.reshape(B, n_blk, Q_BLOCK, MLA_HEADS, QK_NOPE).transpose(1, 0, 2, 3, 4)
    qp_b = q_pe.reshape(B, n_blk, Q_BLOCK, MLA_HEADS, QK_ROPE).transpose(1, 0, 2, 3, 4)

    def block(args):
        qn, qp = args
        s = (jnp.einsum('bqhd,bkhd->bhqk', qn, k_nope)
             + jnp.einsum('bqhr,bkr->bhqk', qp, k_pe))
        p = jax.nn.softmax(s.astype(jnp.float32) * scale, axis=-1).astype(v.dtype)
        return jnp.einsum('bhqk,bkhd->bqhd', p, v)

    o = lax.map(block, (qn_b, qp_b))
    return o.transpose(1, 0, 2, 3, 4).reshape(B, S, MLA_W)


def na_branch(q, k, v, rpb):
    B, S, _ = q.shape
    rows = S // GRID_W
    wr = min(NA_WIN_R, rows)
    wc = NA_WIN_C
    n_keys = wr * wc
    q = q.reshape(B, rows, GRID_W, NA_HEADS, NA_HD).transpose(1, 0, 2, 3, 4)
    k = k.reshape(B, S, NA_HEADS, NA_HD)
    v = v.reshape(B, S, NA_HEADS, NA_HD)
    r = jnp.arange(rows)
    c = jnp.arange(GRID_W)
    rs = jnp.clip(r - wr // 2, 0, rows - wr)
    cs = jnp.clip(c - wc // 2, 0, GRID_W - wc)
    key_r = rs[:, None] + jnp.arange(wr)[None, :]
    key_c = cs[:, None] + jnp.arange(wc)[None, :]
    idx = (key_r[:, None, :, None] * GRID_W + key_c[None, :, None, :]).reshape(rows, GRID_W, n_keys)
    d_row = key_r - r[:, None] + (NA_WIN_R - 1)
    d_col = key_c - c[:, None] + (NA_WIN_C - 1)
    scale = NA_HD ** -0.5

    def row(args):
        q_r, idx_r, dr_r = args
        k_g = k[:, idx_r]
        v_g = v[:, idx_r]
        s = jnp.einsum('bwhd,bwkhd->bhwk', q_r, k_g).astype(jnp.float32) * scale
        bias = rpb[:, dr_r][:, :, d_col]
        bias = bias.transpose(0, 2, 1, 3).reshape(NA_HEADS, GRID_W, n_keys)
        p = jax.nn.softmax(s + bias[None].astype(jnp.float32), axis=-1).astype(v.dtype)
        return jnp.einsum('bhwk,bwkhd->bwhd', p, v_g)

    o = lax.map(row, (q, idx, d_row))
    return o.transpose(1, 0, 2, 3, 4).reshape(B, S, NA_W)


def conv_ffn(h, w_up, conv_w, conv_b, w_down):
    u, g = jnp.split(h @ w_up, 2, axis=-1)
    gp = jnp.pad(g, ((0, 0), (1, 1), (0, 0)))
    g = gp[:, :-2] * conv_w[0] + gp[:, 1:-1] * conv_w[1] + gp[:, 2:] * conv_w[2] + conv_b
    return (jax.nn.silu(g) * u) @ w_down


def trunk(x, norm_mix, w_in, b_gate, norm_q, w_qb, norm_kv, w_kvb, rpb,
          w_br_a, w_br_b, w_o, norm_ffn, w_up, conv_w, conv_b, w_down, norm_final):
    B, S, _ = x.shape
    cuts = list(np.cumsum(SPLITS)[:-1])
    for l in range(DEPTH):
        h = rmsnorm(x, norm_mix[l])
        c_q, c_kv, k_pe, na_q, na_k, na_v, gate_logits = jnp.split(h @ w_in[l], cuts, axis=-1)
        o_a = mla_branch(c_q, c_kv, k_pe, norm_q[l], w_qb[l], norm_kv[l], w_kvb[l])
        o_b = na_branch(na_q, na_k, na_v, rpb[l])
        gates = jax.nn.sigmoid(gate_logits.reshape(B, S, 2, D_MODEL) + b_gate[l])
        merged = gates[:, :, 0] * (o_a @ w_br_a[l]) + gates[:, :, 1] * (o_b @ w_br_b[l])
        x = x + merged @ w_o[l]
        x = x + conv_ffn(rmsnorm(x, norm_ffn[l]), w_up[l], conv_w[l], conv_b[l], w_down[l])
    return rmsnorm(x, norm_final)


def setup_inputs(seed: int = 0) -> dict:
    key = jax.random.key(seed)
    ks = jax.random.split(key, 24)

    def nrm(k, shape, fan):
        return jax.random.normal(k, shape, jnp.float32) * (fan ** -0.5)

    def gain(k, shape):
        return 1.0 + 0.05 * jax.random.normal(k, shape, jnp.float32)

    return {
        'x_prompt': jax.random.normal(ks[0], (BATCH, SEQ, D_MODEL), jnp.float32),
        'x_sample': jax.random.normal(ks[1], (DEC_BATCH, DEC_SEQ, D_MODEL), jnp.float32),
        'norm_mix': gain(ks[2], (DEPTH, D_MODEL)),
        'w_in': nrm(ks[3], (DEPTH, D_MODEL, IN_COLS), D_MODEL),
        'b_gate': 0.1 * jax.random.normal(ks[4], (DEPTH, 2, D_MODEL), jnp.float32),
        'norm_q': gain(ks[5], (DEPTH, Q_LORA)),
        'w_qb': nrm(ks[6], (DEPTH, Q_LORA, MLA_HEADS * (QK_NOPE + QK_ROPE)), Q_LORA),
        'norm_kv': gain(ks[7], (DEPTH, KV_LORA)),
        'w_kvb': nrm(ks[8], (DEPTH, KV_LORA, MLA_HEADS * (QK_NOPE + V_HEAD)), KV_LORA),
        'rpb': 0.1 * jax.random.normal(ks[9], (DEPTH, NA_HEADS, 2 * NA_WIN_R - 1, 2 * NA_WIN_C - 1), jnp.float32),
        'w_br_a': nrm(ks[10], (DEPTH, MLA_W, D_MODEL), MLA_W),
        'w_br_b': nrm(ks[11], (DEPTH, NA_W, D_MODEL), NA_W),
        'w_o': nrm(ks[12], (DEPTH, D_MODEL, D_MODEL), 2 * D_MODEL),
        'norm_ffn': gain(ks[13], (DEPTH, D_MODEL)),
        'w_up': nrm(ks[14], (DEPTH, D_MODEL, 2 * D_FF), D_MODEL),
        'conv_w': nrm(ks[15], (DEPTH, CONV_W, D_FF), CONV_W),
        'conv_b': 0.02 * jax.random.normal(ks[16], (DEPTH, D_FF), jnp.float32),
        'w_down': nrm(ks[17], (DEPTH, D_FF, D_MODEL), D_FF),
        'norm_final': gain(ks[18], (D_MODEL,)),
    }


def reference(x_prompt, x_sample, norm_mix, w_in, b_gate, norm_q, w_qb, norm_kv, w_kvb, rpb,
              w_br_a, w_br_b, w_o, norm_ffn, w_up, conv_w, conv_b, w_down, norm_final):
    y_prompt = trunk(x_prompt, norm_mix, w_in, b_gate, norm_q, w_qb, norm_kv, w_kvb, rpb,
                     w_br_a, w_br_b, w_o, norm_ffn, w_up, conv_w, conv_b, w_down, norm_final)
    y_sample = trunk(x_sample, norm_mix, w_in, b_gate, norm_q, w_qb, norm_kv, w_kvb, rpb,
                     w_br_a, w_br_b, w_o, norm_ffn, w_up, conv_w, conv_b, w_down, norm_final)
    return (y_prompt, y_sample)
```

```cpp
#include <hip/hip_runtime.h>
#include <hip/hip_cooperative_groups.h>
#include <hip/hip_bf16.h>
#include <cstdio>
#include <cstdint>
namespace cg = cooperative_groups;

#ifndef MK_N_LAUNCHES
#define MK_N_LAUNCHES 1
#endif

#define LAS __attribute__((address_space(3)))
typedef unsigned short bf16_t;
typedef short bf16x8 __attribute__((ext_vector_type(8)));
typedef short s16x4 __attribute__((ext_vector_type(4)));
typedef float f32x4 __attribute__((ext_vector_type(4)));
typedef float f32x16 __attribute__((ext_vector_type(16)));
typedef float f32x2 __attribute__((ext_vector_type(2)));
typedef unsigned u32x4 __attribute__((ext_vector_type(4)));
typedef unsigned u32x2 __attribute__((ext_vector_type(2)));

constexpr int TP = 65536, TS = 16384, T = TP + TS;
constexpr int DM = 1024, QL = 768, KVL = 256, ROPE = 32, NAW = 512, DFF = 2816;
constexpr int IN_COLS = 4640, IN_PAD = 4864;
constexpr int NPH = 14;
constexpr float EPS = 1e-6f;
constexpr float LOG2E = 1.4426950408889634f;
constexpr float C2_MLA = 0.10206207261596577f * LOG2E;
constexpr int FA = 1536, FB = 1280;

constexpr size_t MiB = 1u << 20;
constexpr size_t WS_ROPE = 0;
constexpr size_t WS_WIN = 2 * MiB;
constexpr size_t WS_WQB = 12 * MiB;
constexpr size_t WS_WKVB = 14 * MiB;
constexpr size_t WS_WBRA = 15 * MiB;
constexpr size_t WS_WBRB = 16 * MiB;
constexpr size_t WS_WO = 17 * MiB;
constexpr size_t WS_WUP = 19 * MiB;
constexpr size_t WS_WDN = 30 * MiB;
constexpr size_t WS_XN = 40 * MiB;
constexpr size_t WS_KV = 40 * MiB;
constexpr size_t WS_CQKV = 200 * MiB;
constexpr size_t WS_MG = 200 * MiB;
constexpr size_t WS_NAQK = 360 * MiB;
constexpr size_t WS_VT = 520 * MiB;
constexpr size_t WS_Q = 360 * MiB;
constexpr size_t WS_OA = 480 * MiB;
constexpr size_t WS_OB = 600 * MiB;
constexpr size_t WS_MB = 680 * MiB;
constexpr size_t WS_KPE = 840 * MiB;
constexpr size_t WS_G = 200 * MiB;
constexpr size_t WS_ACT = 440 * MiB;
constexpr size_t WS_END = 848 * MiB;

constexpr int RING_BYTES = 131072;
constexpr int LDS_BYTES = 147456;

__device__ __forceinline__ unsigned cvt_pk_bf16(float lo, float hi) {
    f32x2 v = {lo, hi}; typedef __bf16 bf2 __attribute__((ext_vector_type(2)));
    bf2 b = __builtin_convertvector(v, bf2); return __builtin_bit_cast(unsigned, b);
}
__device__ __forceinline__ float bf_lo(unsigned w) { return __uint_as_float(w << 16); }
__device__ __forceinline__ float bf_hi(unsigned w) { return __uint_as_float(w & 0xffff0000u); }
__device__ __forceinline__ void unpack8(u32x4 w, float (&f)[8]) {
    f[0] = bf_lo(w.x); f[1] = bf_hi(w.x); f[2] = bf_lo(w.y); f[3] = bf_hi(w.y);
    f[4] = bf_lo(w.z); f[5] = bf_hi(w.z); f[6] = bf_lo(w.w); f[7] = bf_hi(w.w);
}
__device__ __forceinline__ u32x4 pack8(const float (&f)[8]) {
    u32x4 w; w.x = cvt_pk_bf16(f[0], f[1]); w.y = cvt_pk_bf16(f[2], f[3]); w.z = cvt_pk_bf16(f[4], f[5]); w.w = cvt_pk_bf16(f[6], f[7]); return w;
}
__device__ __forceinline__ float wave_sum(float v) {
#pragma unroll
    for (int o = 1; o < 64; o <<= 1) v += __shfl_xor(v, o);
    return v;
}
__device__ __forceinline__ int seq_pos(int t) { return t < TP ? (t & 4095) : (t - TP); }
__device__ __forceinline__ float sigmoidf_(float x) { return 1.f / (1.f + __expf(-x)); }

namespace pg8 {
constexpr int BM = 256, BK = 64, HALF = 128, HTB = HALF * BK * 2, STAGE_BYTES = 8 * HTB, NXCD = 8, WGM = 8;
__host__ __device__ __forceinline__ int lds_byte(int r, int c) { const int st = (r >> 4) * 2 + (c >> 5), rr = r & 15, cc = c & 31, ob = rr * 64 + cc * 2; return st * 1024 + (ob ^ (((ob >> 9) & 1) << 5)); }
__host__ __device__ __forceinline__ void stage_rc(int b, int& R, int& C) { const int st = b / 1024, sb = b % 1024, swz = sb ^ (((sb >> 9) & 1) << 5); R = (st >> 1) * 16 + swz / 64; C = (st & 1) * 32 + (swz % 64) / 2; }
__host__ __device__ __forceinline__ int perm32(int rho) { const int n = rho >> 4, i = rho & 15; return 8 * (i >> 2) + 4 * n + (i & 3); }

struct Unit { int pm, pn; };
struct Gemm { const bf16_t* A; const bf16_t* Bt; int M, N, K, lda, ldb; };

struct StaticOrder {
    int nM, nN, nwg, G, c;
    __device__ void init(int M, int N, int G_, int c_) { nM = M / BM; nN = N / BM; nwg = nM * nN; G = G_; c = c_; }
    __device__ bool next(int i, Unit& u) const {
        const long L = (long)i * G + c; if (L >= nwg) return false;
        int wgid = (int)L; { const int q = nwg / NXCD, r = nwg % NXCD, xcd = wgid % NXCD, off = wgid / NXCD; wgid = (xcd < r ? xcd * (q + 1) : r * (q + 1) + (xcd - r) * q) + off; }
        const int nig = WGM * nN, gid = wgid / nig, fm = gid * WGM, gsz = (nM - fm) < WGM ? (nM - fm) : WGM;
        u.pm = fm + ((wgid % nig) % gsz); u.pn = (wgid % nig) / gsz; return true;
    }
};

template <class Epi>
__device__ __forceinline__ void gemm_phase(LAS unsigned char* lds, const Gemm g, const StaticOrder& S, const Epi& E) {
    const int tid = threadIdx.x, wid = __builtin_amdgcn_readfirstlane(tid >> 6), lane = tid & 63, wr = wid >> 2, wc = wid & 3, fr = lane & 15, fq = lane >> 4;
    const int K = g.K, nt = K / BK;
    unsigned voffA[2], voffB[2];
#pragma unroll
    for (int i = 0; i < 2; ++i) { int R, C; stage_rc(tid * 16 + i * 8192, R, C); const int Rb = (R & ~31) + perm32(R & 31);
        voffA[i] = (unsigned)(R * g.lda + C) * 2u; voffB[i] = (unsigned)(Rb * g.ldb + C) * 2u; }
    const size_t kstep = (size_t)(BK * 2);
    const size_t hstepA = (size_t)HALF * g.lda * 2, hstepB = (size_t)HALF * g.ldb * 2;
    const size_t tstepA = 2 * hstepA, tstepB = 2 * hstepB;
    const unsigned ldsw = (unsigned)wid * 1024u;
    const int aoff = lds_byte(wr * 64 + fr, fq * 8), boff = lds_byte(wc * 32 + fr, fq * 8);
#define PG8_SA(b, h) (((b) * 2 + (h)) * HTB)
#define PG8_SB(b, h) ((4 + (b) * 2 + (h)) * HTB)
#define PG8_STAGE(bufoff, gbase, voff) do { _Pragma("unroll") for (int _i = 0; _i < 2; ++_i) \
        __builtin_amdgcn_global_load_lds((const unsigned*)((const char*)(gbase) + (voff)[_i]), (LAS unsigned*)(lds + (bufoff) + ldsw + _i * 8192), 16, 0, 0); } while (0)
#define PG8_LDA(dst, b, h) do { _Pragma("unroll") for (int m = 0; m < 4; ++m) _Pragma("unroll") for (int k = 0; k < 2; ++k) dst[m][k] = *(const LAS bf16x8*)(lds + PG8_SA(b, h) + aoff + m * 2048 + k * 1024); } while (0)
#define PG8_LDB(dst, b, h) do { _Pragma("unroll") for (int n = 0; n < 2; ++n) _Pragma("unroll") for (int k = 0; k < 2; ++k) dst[n][k] = *(const LAS bf16x8*)(lds + PG8_SB(b, h) + boff + n * 2048 + k * 1024); } while (0)
#define PG8_MMA(ai, bj, At, Bt) do { __builtin_amdgcn_s_setprio(1); _Pragma("unroll") for (int m = 0; m < 4; ++m) _Pragma("unroll") for (int n = 0; n < 2; ++n) _Pragma("unroll") for (int k = 0; k < 2; ++k) \
        acc[ai][bj][m][n] = __builtin_amdgcn_mfma_f32_16x16x32_bf16(Bt[n][k], At[m][k], acc[ai][bj][m][n], 0, 0, 0); __builtin_amdgcn_s_setprio(0); } while (0)
#define PG8_WAIT_V(n) asm volatile("s_waitcnt vmcnt(" #n ")" ::: "memory")
#define PG8_WAIT_L(n) asm volatile("s_waitcnt lgkmcnt(" #n ")" ::: "memory")
#define PG8_BAR __builtin_amdgcn_s_barrier()
#define PG8_SCHED __builtin_amdgcn_sched_barrier(0)
    Unit cur, nxt; int ui = 0;
    if (!S.next(0, cur)) return;
    f32x4 acc[2][2][4][2];
#pragma unroll
    for (int a = 0; a < 2; ++a)
#pragma unroll
        for (int b = 0; b < 2; ++b)
#pragma unroll
            for (int m = 0; m < 4; ++m)
#pragma unroll
                for (int n = 0; n < 2; ++n) acc[a][b][m][n] = (f32x4){0.f, 0.f, 0.f, 0.f};
    bf16x8 At[4][2], B0[2][2], B1[2][2];
    const char* cA = (const char*)g.A + (size_t)cur.pm * tstepA; const char* cB = (const char*)g.Bt + (size_t)cur.pn * tstepB;
    PG8_STAGE(PG8_SB(0, 0), cB, voffB); PG8_STAGE(PG8_SB(0, 1), cB + hstepB, voffB); PG8_STAGE(PG8_SA(0, 0), cA, voffA); PG8_STAGE(PG8_SA(0, 1), cA + hstepA, voffA);
    if (wr == 1) PG8_BAR;
    PG8_WAIT_V(2); PG8_BAR;
    PG8_STAGE(PG8_SB(1, 0), cB + kstep, voffB); PG8_STAGE(PG8_SA(1, 0), cA + kstep, voffA); PG8_STAGE(PG8_SB(1, 1), cB + hstepB + kstep, voffB);
    PG8_WAIT_V(6); PG8_BAR;
    for (;;) {
        const bool has_next = S.next(ui + 1, nxt);
        const char* nA = has_next ? (const char*)g.A + (size_t)nxt.pm * tstepA : cA; const char* nB = has_next ? (const char*)g.Bt + (size_t)nxt.pn * tstepB : cB;
        for (int t = 0; t < nt; t += 2) {
            const bool last = (t == nt - 2);
            const char* a1 = cA + (size_t)(t + 1) * kstep;
            const char* a2 = last ? nA : cA + (size_t)(t + 2) * kstep; const char* b2 = last ? nB : cB + (size_t)(t + 2) * kstep;
            const char* a3 = a2 + kstep; const char* b3 = b2 + kstep;
            PG8_LDB(B0, 0, 0); PG8_LDB(B1, 0, 1); PG8_SCHED; PG8_LDA(At, 0, 0); PG8_STAGE(PG8_SA(1, 1), a1 + hstepA, voffA);
            PG8_WAIT_V(8); PG8_WAIT_L(0); PG8_BAR; PG8_MMA(0, 0, At, B0); PG8_MMA(0, 1, At, B1); PG8_BAR; PG8_SCHED;
            PG8_LDA(At, 0, 1); PG8_STAGE(PG8_SB(0, 0), b2, voffB); PG8_STAGE(PG8_SB(0, 1), b2 + hstepB, voffB); PG8_STAGE(PG8_SA(0, 0), a2, voffA);
            PG8_WAIT_V(8); PG8_WAIT_L(0); PG8_BAR; PG8_MMA(1, 0, At, B0); PG8_MMA(1, 1, At, B1); PG8_BAR; PG8_SCHED;
            PG8_LDB(B0, 1, 0); PG8_LDB(B1, 1, 1); PG8_SCHED; PG8_LDA(At, 1, 0); PG8_STAGE(PG8_SA(0, 1), a2 + hstepA, voffA);
            PG8_WAIT_V(8); PG8_WAIT_L(0); PG8_BAR; PG8_MMA(0, 0, At, B0); PG8_MMA(0, 1, At, B1); PG8_BAR; PG8_SCHED;
            PG8_LDA(At, 1, 1); PG8_STAGE(PG8_SB(1, 0), b3, voffB); PG8_STAGE(PG8_SB(1, 1), b3 + hstepB, voffB); PG8_STAGE(PG8_SA(1, 0), a3, voffA);
            PG8_WAIT_V(8); PG8_WAIT_L(0); PG8_BAR; PG8_MMA(1, 0, At, B0); PG8_MMA(1, 1, At, B1); PG8_BAR; PG8_SCHED;
        }
        if (wr == 0) PG8_BAR;
        E(acc, cur, wr, wc, fr, fq);
        if (!has_next) break;
#pragma unroll
        for (int a = 0; a < 2; ++a)
#pragma unroll
            for (int b = 0; b < 2; ++b)
#pragma unroll
                for (int m = 0; m < 4; ++m)
#pragma unroll
                    for (int n = 0; n < 2; ++n) acc[a][b][m][n] = (f32x4){0.f, 0.f, 0.f, 0.f};
        cur = nxt; cA = nA; cB = nB; ++ui;
        if (wr == 1) PG8_BAR;
    }
    PG8_WAIT_V(0);
    PG8_BAR;
#undef PG8_SA
#undef PG8_SB
#undef PG8_STAGE
#undef PG8_LDA
#undef PG8_LDB
#undef PG8_MMA
#undef PG8_WAIT_V
#undef PG8_WAIT_L
#undef PG8_BAR
#undef PG8_SCHED
}

#define EPI_LOOP_BEGIN \
    _Pragma("unroll") for (int ai = 0; ai < 2; ++ai) _Pragma("unroll") for (int m = 0; m < 4; ++m) { const int row = u.pm * BM + ai * HALF + wr * 64 + m * 16 + fr; \
    _Pragma("unroll") for (int bj = 0; bj < 2; ++bj) { const int tcol = bj * HALF + wc * 32 + 8 * fq; \
        float v[8]; { const f32x4 a0 = acc[ai][bj][m][0], a1 = acc[ai][bj][m][1]; v[0] = a0[0]; v[1] = a0[1]; v[2] = a0[2]; v[3] = a0[3]; v[4] = a1[0]; v[5] = a1[1]; v[6] = a1[2]; v[7] = a1[3]; }
#define EPI_LOOP_END } }

struct EpiPlain {
    bf16_t* O; int ldc; float scale;
    __device__ __forceinline__ void operator()(const f32x4 (&acc)[2][2][4][2], const Unit& u, int wr, int wc, int fr, int fq) const {
        EPI_LOOP_BEGIN
#pragma unroll
            for (int j = 0; j < 8; ++j) v[j] *= scale;
            *(u32x4*)(O + (size_t)row * ldc + u.pn * BM + tcol) = pack8(v);
        EPI_LOOP_END
    }
};
struct EpiIn {
    bf16_t *cqkv, *naqk, *vt, *gates, *kpe; const float* bgate;
    __device__ __forceinline__ void operator()(const f32x4 (&acc)[2][2][4][2], const Unit& u, int wr, int wc, int fr, int fq) const {
        const int pn = u.pn;
        if (pn < 8) {
            bf16_t* O = pn < 4 ? cqkv : naqk; const int cb = (pn & 3) * BM;
            EPI_LOOP_BEGIN
                *(u32x4*)(O + (size_t)row * 1024 + cb + tcol) = pack8(v);
            EPI_LOOP_END
        } else if (pn < 10) {
            const int cb = (pn - 8) * BM;
            EPI_LOOP_BEGIN
#pragma unroll
                for (int j = 0; j < 8; j += 2) { const unsigned w = cvt_pk_bf16(v[j], v[j + 1]);
                    vt[(size_t)(cb + tcol + j) * T + row] = (bf16_t)(w & 0xffffu); vt[(size_t)(cb + tcol + j + 1) * T + row] = (bf16_t)(w >> 16); }
            EPI_LOOP_END
        } else if (pn < 18) {
            const int cb = (pn - 10) * BM;
            EPI_LOOP_BEGIN
                const f32x4 b0 = *(const f32x4*)(bgate + cb + tcol), b1 = *(const f32x4*)(bgate + cb + tcol + 4);
                v[0] = sigmoidf_(v[0] + b0[0]); v[1] = sigmoidf_(v[1] + b0[1]); v[2] = sigmoidf_(v[2] + b0[2]); v[3] = sigmoidf_(v[3] + b0[3]);
                v[4] = sigmoidf_(v[4] + b1[0]); v[5] = sigmoidf_(v[5] + b1[1]); v[6] = sigmoidf_(v[6] + b1[2]); v[7] = sigmoidf_(v[7] + b1[3]);
                *(u32x4*)(gates + (size_t)row * 2048 + cb + tcol) = pack8(v);
            EPI_LOOP_END
        } else {
            if (wc == 0) {
                EPI_LOOP_BEGIN
                    if (bj == 0) *(u32x4*)(kpe + (size_t)row * 32 + tcol) = pack8(v);
                EPI_LOOP_END
            }
        }
    }
};
struct EpiQ {
    bf16_t* Q; const f32x2* rope; float scale;
    __device__ __forceinline__ void operator()(const f32x4 (&acc)[2][2][4][2], const Unit& u, int wr, int wc, int fr, int fq) const {
        if (u.pn < 2) {
            EPI_LOOP_BEGIN
#pragma unroll
                for (int j = 0; j < 8; ++j) v[j] *= scale;
                *(u32x4*)(Q + (size_t)row * 768 + u.pn * BM + tcol) = pack8(v);
            EPI_LOOP_END
        } else {
            EPI_LOOP_BEGIN
                const f32x2* rp = rope + (size_t)seq_pos(row) * 16 + (fq & 1) * 8;
#pragma unroll
                for (int j = 0; j < 8; ++j) { const float other = __shfl_xor(v[j], 32); const f32x2 cs = rp[j];
                    const float x1 = (fq < 2) ? v[j] : other, x2 = (fq < 2) ? other : v[j];
                    v[j] = ((fq < 2) ? (x1 * cs.x - x2 * cs.y) : (x1 * cs.y + x2 * cs.x)) * scale; }
                *(u32x4*)(Q + (size_t)row * 768 + 512 + tcol) = pack8(v);
            EPI_LOOP_END
        }
    }
};
struct EpiGateB {
    bf16_t* O; const bf16_t* gates;
    __device__ __forceinline__ void operator()(const f32x4 (&acc)[2][2][4][2], const Unit& u, int wr, int wc, int fr, int fq) const {
        EPI_LOOP_BEGIN
            const int col = u.pn * BM + tcol; float g[8]; unpack8(*(const u32x4*)(gates + (size_t)row * 2048 + 1024 + col), g);
#pragma unroll
            for (int j = 0; j < 8; ++j) v[j] *= g[j];
            *(u32x4*)(O + (size_t)row * 1024 + col) = pack8(v);
        EPI_LOOP_END
    }
};
struct EpiMerge {
    bf16_t* O; const bf16_t* gates; const bf16_t* mb;
    __device__ __forceinline__ void operator()(const f32x4 (&acc)[2][2][4][2], const Unit& u, int wr, int wc, int fr, int fq) const {
        EPI_LOOP_BEGIN
            const int col = u.pn * BM + tcol; float g[8], b[8];
            unpack8(*(const u32x4*)(gates + (size_t)row * 2048 + col), g); unpack8(*(const u32x4*)(mb + (size_t)row * 1024 + col), b);
#pragma unroll
            for (int j = 0; j < 8; ++j) v[j] = v[j] * g[j] + b[j];
            *(u32x4*)(O + (size_t)row * 1024 + col) = pack8(v);
        EPI_LOOP_END
    }
};
struct EpiResid {
    const float* xp; const float* xs; float* out;
    __device__ __forceinline__ void operator()(const f32x4 (&acc)[2][2][4][2], const Unit& u, int wr, int wc, int fr, int fq) const {
        EPI_LOOP_BEGIN
            const int col = u.pn * BM + tcol;
            const float* bp = xp ? (row < TP ? xp + (size_t)row * DM : xs + (size_t)(row - TP) * DM) : out + (size_t)row * DM;
            const f32x4 b0 = *(const f32x4*)(bp + col), b1 = *(const f32x4*)(bp + col + 4);
            f32x4 o0 = {v[0] + b0[0], v[1] + b0[1], v[2] + b0[2], v[3] + b0[3]}, o1 = {v[4] + b1[0], v[5] + b1[1], v[6] + b1[2], v[7] + b1[3]};
            *(f32x4*)(out + (size_t)row * DM + col) = o0; *(f32x4*)(out + (size_t)row * DM + col + 4) = o1;
        EPI_LOOP_END
    }
};
struct EpiConv {
    bf16_t* O; const bf16_t* G; int ldg; const float* cw; const float* cb; int ch_off;
    __device__ __forceinline__ void operator()(const f32x4 (&acc)[2][2][4][2], const Unit& u, int wr, int wc, int fr, int fq) const {
#pragma unroll
        for (int bj = 0; bj < 2; ++bj) {
            const int lc = u.pn * BM + bj * HALF + wc * 32 + 8 * fq, ch = ch_off + lc;
            float w0[8], w1[8], w2[8], bb[8];
#pragma unroll
            for (int j = 0; j < 8; j += 4) { const f32x4 a = *(const f32x4*)(cw + ch + j), b = *(const f32x4*)(cw + DFF + ch + j), c = *(const f32x4*)(cw + 2 * DFF + ch + j), d = *(const f32x4*)(cb + ch + j);
#pragma unroll
                for (int i = 0; i < 4; ++i) { w0[j + i] = a[i]; w1[j + i] = b[i]; w2[j + i] = c[i]; bb[j + i] = d[i]; } }
#pragma unroll
            for (int ai = 0; ai < 2; ++ai)
#pragma unroll
                for (int m = 0; m < 4; ++m) {
                    const int row = u.pm * BM + ai * HALF + wr * 64 + m * 16 + fr;
                    const bool hasl = row < TP ? ((row & 4095) != 0) : (row != TP);
                    const bool hasr = row < TP ? ((row & 4095) != 4095) : (row != T - 1);
                    const bf16_t* gp = G + (size_t)row * ldg + lc;
                    float gm[8], gc[8], gn[8];
                    unpack8(*(const u32x4*)gp, gc);
                    if (hasl) unpack8(*(const u32x4*)(gp - ldg), gm); else { _Pragma("unroll") for (int j = 0; j < 8; ++j) gm[j] = 0.f; }
                    if (hasr) unpack8(*(const u32x4*)(gp + ldg), gn); else { _Pragma("unroll") for (int j = 0; j < 8; ++j) gn[j] = 0.f; }
                    const f32x4 a0 = acc[ai][bj][m][0], a1 = acc[ai][bj][m][1];
                    float uu[8] = {a0[0], a0[1], a0[2], a0[3], a1[0], a1[1], a1[2], a1[3]}; float o[8];
#pragma unroll
                    for (int j = 0; j < 8; ++j) { const float gg = gm[j] * w0[j] + gc[j] * w1[j] + gn[j] * w2[j] + bb[j]; o[j] = gg * sigmoidf_(gg) * uu[j]; }
                    *(u32x4*)(O + (size_t)row * ldg + lc) = pack8(o);
                }
        }
    }
};
}

namespace mla {
constexpr int NW = 8, QBLK = 32, QB = 256, KVBLK = 64;
constexpr int NSLOT = 3, KSLOT = 12288, VSLOT = 8192;
constexpr int LDS_K = 0, LDS_V = NSLOT * KSLOT, LDS_WS = LDS_V + NSLOT * VSLOT, LDS_OST = LDS_WS + NW * 64 * 4, LDS_TOTAL = LDS_OST + NW * 4096;
static_assert(LDS_TOTAL <= RING_BYTES, "mla lds");
typedef LAS const char* lds_cptr;
__device__ __forceinline__ int crow(int r, int hi) { return (r & 3) + 8 * (r >> 2) + 4 * hi; }
__device__ __forceinline__ void glds16(const void* gsrc, unsigned lds_dst) { unsigned keep;
    asm volatile("s_mov_b32 %0, m0\n\ts_mov_b32 m0, %2\n\ts_nop 0\n\tglobal_load_lds_dwordx4 %1, off\n\ts_mov_b32 m0, %0" : "=&s"(keep) : "v"(gsrc), "s"(lds_dst) : "memory"); }
#define MLA_WAIT_BAR(N) asm volatile("s_waitcnt vmcnt(" #N ") lgkmcnt(0)\n\ts_barrier" ::: "memory")

__device__ __forceinline__ float rowmax32(const f32x16& p0, const f32x16& p1) {
    float a = __builtin_fmaxf(p0[0], p1[0]);
#pragma unroll
    for (int r = 1; r < 16; ++r) a = __builtin_fmaxf(a, __builtin_fmaxf(p0[r], p1[r]));
    auto rr = __builtin_amdgcn_permlane32_swap(__float_as_uint(a), __float_as_uint(a), false, false);
    return __builtin_fmaxf(__uint_as_float(rr[0]), __uint_as_float(rr[1]));
}
__device__ __forceinline__ void pv(f32x16* o, int vb, bf16x8 pa0, bf16x8 pa1, bf16x8 pa2, bf16x8 pa3) {
#pragma unroll
    for (int d0 = 0; d0 < 2; ++d0) { s16x4 lo[4], hi[4];
#pragma unroll
        for (int ks = 0; ks < 4; ++ks) {
            asm volatile("ds_read_b64_tr_b16 %0,%1 offset:%c2" : "=&v"(lo[ks]) : "v"(vb), "i"(d0 * 4096 + ks * 1024) : "memory");
            asm volatile("ds_read_b64_tr_b16 %0,%1 offset:%c2" : "=&v"(hi[ks]) : "v"(vb), "i"(d0 * 4096 + ks * 1024 + 512) : "memory"); }
        asm volatile("s_waitcnt lgkmcnt(0)" ::: "memory"); __builtin_amdgcn_sched_barrier(0);
#define MLA_PK(k) (bf16x8){lo[k][0], lo[k][1], lo[k][2], lo[k][3], hi[k][0], hi[k][1], hi[k][2], hi[k][3]}
        o[d0] = __builtin_amdgcn_mfma_f32_32x32x16_bf16(pa0, MLA_PK(0), o[d0], 0, 0, 0);
        o[d0] = __builtin_amdgcn_mfma_f32_32x32x16_bf16(pa1, MLA_PK(1), o[d0], 0, 0, 0);
        o[d0] = __builtin_amdgcn_mfma_f32_32x32x16_bf16(pa2, MLA_PK(2), o[d0], 0, 0, 0);
        o[d0] = __builtin_amdgcn_mfma_f32_32x32x16_bf16(pa3, MLA_PK(3), o[d0], 0, 0, 0);
#undef MLA_PK
    }
}

__device__ __forceinline__ void attn_unit(int tb, int NT, int h, int q0, const bf16_t* Q, const bf16_t* __restrict__ KV, const bf16_t* __restrict__ KPE, bf16_t* OA, LAS char* shm) {
    const int tid = threadIdx.x, lane = tid & 63, r32 = lane & 31, hi = lane >> 5; const int wid = __builtin_amdgcn_readfirstlane(tid >> 6);
    const unsigned lds0 = (unsigned)(uintptr_t)shm;
    LAS float* wsf = (LAS float*)(shm + LDS_WS) + wid * 64;
    asm volatile("s_waitcnt vmcnt(0)" ::: "memory");
    const bf16_t* Qw = Q + (size_t)(tb + q0 + wid * QBLK + r32) * 768;
    bf16x8 qr[6];
#pragma unroll
    for (int d0 = 0; d0 < 4; ++d0) qr[d0] = *(const bf16x8*)(Qw + h * 64 + d0 * 16 + hi * 8);
#pragma unroll
    for (int d0 = 0; d0 < 2; ++d0) qr[4 + d0] = *(const bf16x8*)(Qw + 512 + h * 32 + d0 * 16 + hi * 8);
    const bf16_t* ksrc = KV + (size_t)(tb + lane) * 1024 + h * 64 + wid * 8;
    const bf16_t* rsrc = KPE + (size_t)(tb + lane) * 32 + (wid & 3) * 8;
    const bf16_t* vsrc = KV + (size_t)(tb + 16 * (wid & 3) + (lane >> 2)) * 1024 + 512 + h * 64 + (wid >> 2) * 32 + (lane & 3) * 8;
    const unsigned kdst = lds0 + LDS_K + wid * 1024, rdst = lds0 + LDS_K + (8 + (wid & 3)) * 1024, vdst = lds0 + LDS_V + wid * 1024;
#define MLA_DMA(t, s) do { glds16(ksrc + (size_t)(t) * KVBLK * 1024, (unsigned)__builtin_amdgcn_readfirstlane(kdst + (s) * KSLOT)); \
        glds16(rsrc + (size_t)(t) * KVBLK * 32, (unsigned)__builtin_amdgcn_readfirstlane(rdst + (s) * KSLOT)); \
        glds16(vsrc + (size_t)(t) * KVBLK * 1024, (unsigned)__builtin_amdgcn_readfirstlane(vdst + (s) * VSLOT)); } while (0)
    const int vb0 = (int)(lds0 + LDS_V) + ((lane >> 4) & 1) * 32 + (lane & 3) * 8 + (4 * hi + ((lane & 15) >> 2)) * 64;
    const lds_cptr kp0 = (lds_cptr)shm + LDS_K + hi * 1024 + r32 * 16;
    MLA_DMA(0, 0); MLA_DMA(1, 1);
    float mhat = 0.f, l_reg = 0.f; f32x16 o[2]; o[0] = f32x16{}; o[1] = f32x16{}; f32x16 negm = f32x16{};
    int slot = 0;
    for (int t = 0; t < NT; ++t) {
        if (t + 1 < NT) { MLA_WAIT_BAR(3); } else { MLA_WAIT_BAR(0); }
        { const int s2 = (slot == 0) ? 2 : slot - 1; if (t + 2 < NT) MLA_DMA(t + 2, s2); }
        f32x16 p0, p1;
        { const lds_cptr kb = kp0 + slot * KSLOT;
#pragma unroll
          for (int d0 = 0; d0 < 6; ++d0) {
              const bf16x8 b0 = *(const LAS bf16x8*)(kb + d0 * 2048);
              const bf16x8 b1 = *(const LAS bf16x8*)(kb + d0 * 2048 + 512);
              if (d0 == 0) { p0 = __builtin_amdgcn_mfma_f32_32x32x16_bf16(b0, qr[0], negm, 0, 0, 0); p1 = __builtin_amdgcn_mfma_f32_32x32x16_bf16(b1, qr[0], negm, 0, 0, 0); }
              else { p0 = __builtin_amdgcn_mfma_f32_32x32x16_bf16(b0, qr[d0], p0, 0, 0, 0); p1 = __builtin_amdgcn_mfma_f32_32x32x16_bf16(b1, qr[d0], p1, 0, 0, 0); } } }
        const float rm = rowmax32(p0, p1);
        if (t == 0) {
            mhat = rm;
#pragma unroll
            for (int r = 0; r < 16; ++r) { p0[r] -= rm; p1[r] -= rm; negm[r] = -mhat; }
        } else if (__any(rm > 8.0f)) {
            const float dl = __builtin_fmaxf(rm, 0.f); mhat += dl;
#pragma unroll
            for (int r = 0; r < 16; ++r) { p0[r] -= dl; p1[r] -= dl; negm[r] = -mhat; }
            const float f = __builtin_amdgcn_exp2f(-dl); l_reg *= f;
            if (hi == 0) wsf[r32] = f;
            asm volatile("s_waitcnt lgkmcnt(0)" ::: "memory");
#pragma unroll
            for (int r = 0; r < 16; ++r) { const float fr_ = wsf[crow(r, hi)]; o[0][r] *= fr_; o[1][r] *= fr_; }
        }
        float sacc = 0.f;
#pragma unroll
        for (int r = 0; r < 16; ++r) { p0[r] = __builtin_amdgcn_exp2f(p0[r]); p1[r] = __builtin_amdgcn_exp2f(p1[r]); sacc += p0[r] + p1[r]; }
        l_reg += sacc;
        u32x4 pw0, pw1, pw2, pw3;
        pw0 = (u32x4){cvt_pk_bf16(p0[0], p0[1]), cvt_pk_bf16(p0[2], p0[3]), cvt_pk_bf16(p0[4], p0[5]), cvt_pk_bf16(p0[6], p0[7])};
        pw1 = (u32x4){cvt_pk_bf16(p0[8], p0[9]), cvt_pk_bf16(p0[10], p0[11]), cvt_pk_bf16(p0[12], p0[13]), cvt_pk_bf16(p0[14], p0[15])};
        pw2 = (u32x4){cvt_pk_bf16(p1[0], p1[1]), cvt_pk_bf16(p1[2], p1[3]), cvt_pk_bf16(p1[4], p1[5]), cvt_pk_bf16(p1[6], p1[7])};
        pw3 = (u32x4){cvt_pk_bf16(p1[8], p1[9]), cvt_pk_bf16(p1[10], p1[11]), cvt_pk_bf16(p1[12], p1[13]), cvt_pk_bf16(p1[14], p1[15])};
        pv(o, vb0 + slot * VSLOT, __builtin_bit_cast(bf16x8, pw0), __builtin_bit_cast(bf16x8, pw1), __builtin_bit_cast(bf16x8, pw2), __builtin_bit_cast(bf16x8, pw3));
        slot = (slot == 2) ? 0 : slot + 1;
    }
    { auto rr = __builtin_amdgcn_permlane32_swap(__float_as_uint(l_reg), __float_as_uint(l_reg), false, false); l_reg = __uint_as_float(rr[0]) + __uint_as_float(rr[1]); }
    if (hi == 0) wsf[32 + r32] = l_reg;
    asm volatile("s_waitcnt lgkmcnt(0)" ::: "memory");
    float rli[16];
#pragma unroll
    for (int r = 0; r < 16; ++r) rli[r] = __builtin_amdgcn_rcpf(wsf[32 + crow(r, hi)]);
    bf16_t* Ow = OA + (size_t)(tb + q0 + wid * QBLK) * 512 + h * 64;
    { LAS bf16_t* stg = (LAS bf16_t*)(shm + LDS_OST) + wid * 2048;
#pragma unroll
      for (int r = 0; r < 16; ++r) { const int orow = crow(r, hi);
#pragma unroll
          for (int d0 = 0; d0 < 2; ++d0) stg[orow * 64 + d0 * 32 + r32] = (bf16_t)(cvt_pk_bf16(o[d0][r] * rli[r], 0.f) & 0xffffu); }
      asm volatile("s_waitcnt lgkmcnt(0)" ::: "memory");
#pragma unroll
      for (int i = 0; i < 4; ++i) { const int row = i * 8 + (lane >> 3), ch = lane & 7; const u32x4 v = *(const LAS u32x4*)(stg + row * 64 + ch * 8); *(u32x4*)(Ow + (size_t)row * 512 + ch * 8) = v; } }
    asm volatile("s_waitcnt lgkmcnt(0)\n\ts_barrier" ::: "memory");
#undef MLA_DMA
}
}

struct Args { const float* in[19]; float* out; unsigned char* ws; int ph_lo, ph_hi; };

__device__ __forceinline__ void transpose_item(const float* W, int Nsrc, bf16_t* WT, int K, int k0, int dst_n0, int src_n0, LAS float* scr, int lane) {
#pragma unroll 8
    for (int i = 0; i < 32; ++i) { const int kk = 2 * i + (lane >> 5); scr[kk * 33 + (lane & 31)] = src_n0 >= 0 ? W[(size_t)(k0 + kk) * Nsrc + src_n0 + (lane & 31)] : 0.f; }
    asm volatile("s_waitcnt lgkmcnt(0)" ::: "memory");
    const int c = lane & 7;
#pragma unroll
    for (int j = 0; j < 4; ++j) { const int n = (lane >> 3) + 8 * j; const LAS float* s = scr + (8 * c) * 33 + n;
        u32x4 o; o.x = cvt_pk_bf16(s[0 * 33], s[1 * 33]); o.y = cvt_pk_bf16(s[2 * 33], s[3 * 33]); o.z = cvt_pk_bf16(s[4 * 33], s[5 * 33]); o.w = cvt_pk_bf16(s[6 * 33], s[7 * 33]);
        *(u32x4*)(WT + (size_t)(dst_n0 + n) * K + k0 + 8 * c) = o; }
    asm volatile("s_waitcnt lgkmcnt(0)" ::: "memory");
}
__device__ __forceinline__ void rms_row_bf16(const float* xrow, const float* gain, bf16_t* orow, int lane) {
    const f32x4* xr = (const f32x4*)xrow + lane; const f32x4* gr = (const f32x4*)gain + lane;
    f32x4 v[4]; float s = 0.f;
#pragma unroll
    for (int j = 0; j < 4; ++j) { v[j] = xr[64 * j]; s += (v[j].x * v[j].x + v[j].y * v[j].y) + (v[j].z * v[j].z + v[j].w * v[j].w); }
    const float rstd = 1.f / sqrtf(wave_sum(s) * (1.f / DM) + EPS);
    u32x2* o8 = (u32x2*)orow + lane;
#pragma unroll
    for (int j = 0; j < 4; ++j) { const f32x4 g = gr[64 * j]; u32x2 w; w.x = cvt_pk_bf16(v[j].x * rstd * g.x, v[j].y * rstd * g.y); w.y = cvt_pk_bf16(v[j].z * rstd * g.z, v[j].w * rstd * g.w); o8[64 * j] = w; }
}

__global__ void __launch_bounds__(512, 2) mega_fwd(Args args) {
    extern __shared__ __attribute__((aligned(16))) unsigned char lds_raw[];
    LAS unsigned char* lds = (LAS unsigned char*)lds_raw;
    const int tid = threadIdx.x, lane = tid & 63, wave = __builtin_amdgcn_readfirstlane(tid >> 6);
    const int G = gridDim.x, bx = blockIdx.x;
    const int vcu = (G % 8 == 0) ? (bx % 8) * (G / 8) + bx / 8 : bx;
    const int gw = vcu * 8 + wave, NGW = G * 8;
    unsigned char* ws = args.ws;
    const float* xp = args.in[0]; const float* xs = args.in[1];
    const float* norm_mix = args.in[2]; const float* w_in = args.in[3]; const float* b_gate = args.in[4]; const float* norm_q = args.in[5];
    const float* w_qb = args.in[6]; const float* norm_kv = args.in[7]; const float* w_kvb = args.in[8]; const float* rpb = args.in[9];
    const float* w_br_a = args.in[10]; const float* w_br_b = args.in[11]; const float* w_o = args.in[12]; const float* norm_ffn = args.in[13];
    const float* w_up = args.in[14]; const float* conv_w = args.in[15]; const float* conv_b = args.in[16]; const float* w_down = args.in[17]; const float* norm_final = args.in[18];
    float* out = args.out;
    f32x2* ROPE_T = (f32x2*)(ws + WS_ROPE);
    bf16_t* WIN = (bf16_t*)(ws + WS_WIN); bf16_t* WQB = (bf16_t*)(ws + WS_WQB); bf16_t* WKVB = (bf16_t*)(ws + WS_WKVB);
    bf16_t* WBRA = (bf16_t*)(ws + WS_WBRA); bf16_t* WBRB = (bf16_t*)(ws + WS_WBRB); bf16_t* WO = (bf16_t*)(ws + WS_WO);
    bf16_t* WUP = (bf16_t*)(ws + WS_WUP); bf16_t* WDN = (bf16_t*)(ws + WS_WDN);
    bf16_t* XN = (bf16_t*)(ws + WS_XN); bf16_t* KV = (bf16_t*)(ws + WS_KV); bf16_t* CQKV = (bf16_t*)(ws + WS_CQKV); bf16_t* MG = (bf16_t*)(ws + WS_MG);
    bf16_t* NAQK = (bf16_t*)(ws + WS_NAQK); bf16_t* VT = (bf16_t*)(ws + WS_VT); bf16_t* Qb = (bf16_t*)(ws + WS_Q); bf16_t* OA = (bf16_t*)(ws + WS_OA);
    bf16_t* OB = (bf16_t*)(ws + WS_OB); bf16_t* MB = (bf16_t*)(ws + WS_MB); bf16_t* KPE = (bf16_t*)(ws + WS_KPE);
    bf16_t* GB = (bf16_t*)(ws + WS_G); bf16_t* ACT = (bf16_t*)(ws + WS_ACT);
    bf16_t* GATES = (bf16_t*)out;

    const int lo = args.ph_lo, hi = args.ph_hi;
#define IN(k) (lo <= (k) && (k) < hi)
#define SEAM(k) do { if (IN(k) && IN((k) + 1)) { __threadfence(); cg::this_grid().sync(); } } while (0)

    if (IN(0)) {
        LAS float* scr = (LAS float*)(lds + wave * 16384);
        constexpr int I_IN = (DM / 64) * (IN_PAD / 32), I_QB = (QL / 64) * (768 / 32), I_KVB = (KVL / 64) * (1024 / 32), I_BR = (512 / 64) * (1024 / 32),
                      I_O = (DM / 64) * (1024 / 32), I_UP = (DM / 64) * (5632 / 32), I_DN = (DFF / 64) * (1024 / 32);
        constexpr int NITEMS = I_IN + I_QB + I_KVB + 2 * I_BR + I_O + I_UP + I_DN;
        for (int it = gw; it < NITEMS; it += NGW) {
            int r = it;
            if (r < I_IN) { const int nb = r % (IN_PAD / 32), kb = r / (IN_PAD / 32), n0 = nb * 32; const int s0 = n0 < 1024 ? n0 : (n0 < 4608 ? n0 + 32 : (n0 < 4640 ? n0 - 3584 : -1));
                transpose_item(w_in, IN_COLS, WIN, DM, kb * 64, n0, s0, scr, lane); continue; } r -= I_IN;
            if (r < I_QB) { const int nb = r % 24, kb = r / 24, n0 = nb * 32; const int s0 = n0 < 512 ? (n0 >> 6) * 96 + (n0 & 63) : ((n0 - 512) >> 5) * 96 + 64;
                transpose_item(w_qb, 768, WQB, QL, kb * 64, n0, s0, scr, lane); continue; } r -= I_QB;
            if (r < I_KVB) { const int nb = r % 32, kb = r / 32, n0 = nb * 32; const int s0 = n0 < 512 ? (n0 >> 6) * 128 + (n0 & 63) : ((n0 - 512) >> 6) * 128 + 64 + ((n0 - 512) & 63);
                transpose_item(w_kvb, 1024, WKVB, KVL, kb * 64, n0, s0, scr, lane); continue; } r -= I_KVB;
            if (r < I_BR) { const int nb = r % 32, kb = r / 32; transpose_item(w_br_a, 1024, WBRA, 512, kb * 64, nb * 32, nb * 32, scr, lane); continue; } r -= I_BR;
            if (r < I_BR) { const int nb = r % 32, kb = r / 32; transpose_item(w_br_b, 1024, WBRB, 512, kb * 64, nb * 32, nb * 32, scr, lane); continue; } r -= I_BR;
            if (r < I_O) { const int nb = r % 32, kb = r / 32; transpose_item(w_o, 1024, WO, DM, kb * 64, nb * 32, nb * 32, scr, lane); continue; } r -= I_O;
            if (r < I_UP) { const int nb = r % 176, kb = r / 176; transpose_item(w_up, 5632, WUP, DM, kb * 64, nb * 32, nb * 32, scr, lane); continue; } r -= I_UP;
            { const int nb = r % 32, kb = r / 32; transpose_item(w_down, 1024, WDN, DFF, kb * 64, nb * 32, nb * 32, scr, lane); }
        }
        for (int m = gw; m < T; m += NGW) rms_row_bf16(m < TP ? xp + (size_t)m * DM : xs + (size_t)(m - TP) * DM, norm_mix, XN + (size_t)m * DM, lane);
        for (int i = vcu * 512 + tid; i < TS * 16; i += G * 512) { const int s = i >> 4, k = i & 15;
            double inv = 1.0; for (int q = 0; q < k; ++q) inv *= 0.5623413251903491;
            const double ang = (double)s * inv; const double nrev = __builtin_rint(ang * 0.15915494309189535);
            const float red = (float)(ang - nrev * 6.283185307179586);
            ROPE_T[i] = (f32x2){cosf(red), sinf(red)}; }
    }
    SEAM(0);
    if (IN(1)) {
        pg8::Gemm g{XN, WIN, T, IN_PAD, DM, DM, DM}; pg8::StaticOrder S; S.init(T, IN_PAD, G, bx);
        pg8::EpiIn E{CQKV, NAQK, VT, GATES, KPE, b_gate};
        pg8::gemm_phase(lds, g, S, E);
    }
    SEAM(1);
    if (IN(2)) {
        for (int t = gw; t < T; t += NGW) {
            bf16_t* row = CQKV + (size_t)t * 1024;
            u32x2 w[3]; float f[3][4]; float s = 0.f;
#pragma unroll
            for (int j = 0; j < 3; ++j) { w[j] = *(const u32x2*)(row + j * 256 + lane * 4); f[j][0] = bf_lo(w[j].x); f[j][1] = bf_hi(w[j].x); f[j][2] = bf_lo(w[j].y); f[j][3] = bf_hi(w[j].y);
                s += (f[j][0] * f[j][0] + f[j][1] * f[j][1]) + (f[j][2] * f[j][2] + f[j][3] * f[j][3]); }
            const u32x2 wk = *(const u32x2*)(row + 768 + lane * 4); float fk[4] = {bf_lo(wk.x), bf_hi(wk.x), bf_lo(wk.y), bf_hi(wk.y)};
            float sk = (fk[0] * fk[0] + fk[1] * fk[1]) + (fk[2] * fk[2] + fk[3] * fk[3]);
            const float rq = 1.f / sqrtf(wave_sum(s) * (1.f / QL) + EPS), rk = 1.f / sqrtf(wave_sum(sk) * (1.f / KVL) + EPS);
#pragma unroll
            for (int j = 0; j < 3; ++j) { const f32x4 gq = *(const f32x4*)(norm_q + j * 256 + lane * 4); u32x2 o; o.x = cvt_pk_bf16(f[j][0] * rq * gq.x, f[j][1] * rq * gq.y); o.y = cvt_pk_bf16(f[j][2] * rq * gq.z, f[j][3] * rq * gq.w);
                *(u32x2*)(row + j * 256 + lane * 4) = o; }
            { const f32x4 gk = *(const f32x4*)(norm_kv + lane * 4); u32x2 o; o.x = cvt_pk_bf16(fk[0] * rk * gk.x, fk[1] * rk * gk.y); o.y = cvt_pk_bf16(fk[2] * rk * gk.z, fk[3] * rk * gk.w);
                *(u32x2*)(row + 768 + lane * 4) = o; }
            if (lane < 16) { bf16_t* kp = KPE + (size_t)t * 32; const float x1 = __uint_as_float((unsigned)kp[lane] << 16), x2 = __uint_as_float((unsigned)kp[16 + lane] << 16);
                const f32x2 cs = ROPE_T[(size_t)seq_pos(t) * 16 + lane];
                const unsigned o1 = cvt_pk_bf16(x1 * cs.x - x2 * cs.y, 0.f), o2 = cvt_pk_bf16(x1 * cs.y + x2 * cs.x, 0.f);
                kp[lane] = (bf16_t)(o1 & 0xffffu); kp[16 + lane] = (bf16_t)(o2 & 0xffffu); }
        }
        LAS float* rpbl = (LAS float*)lds;
        for (int i = tid; i < 8 * 15 * 31; i += 512) rpbl[i] = rpb[i];
        __syncthreads();
        const int n16 = lane & 15, g4 = lane >> 4;
        for (int uidx = gw; uidx < (T / 16) * 8; uidx += NGW) {
            const int h = uidx & 7, t0 = (uidx >> 3) * 16;
            const int tb = t0 < TP ? (t0 & ~4095) : TP, rows = t0 < TP ? 64 : 256;
            const int sp = t0 - tb, r = sp >> 6, c0 = sp & 63, cbk = c0 >> 4;
            const int kc0 = cbk == 0 ? 0 : (cbk == 1 ? 8 : (cbk == 2 ? 24 : 32));
            const int rs = min(max(r - 4, 0), rows - 8);
            const bf16_t* qp = NAQK + (size_t)(t0 + n16) * 1024 + h * 64 + 8 * g4;
            const bf16x8 aq0 = *(const bf16x8*)qp, aq1 = *(const bf16x8*)(qp + 32);
            f32x4 sc[16];
#pragma unroll
            for (int j = 0; j < 16; ++j) { const int kr = j >> 1, kcb = (j & 1) * 16; const int tk = tb + (rs + kr) * 64 + kc0 + kcb + n16;
                const bf16_t* kp = NAQK + (size_t)tk * 1024 + 512 + h * 64 + 8 * g4;
                const bf16x8 k0 = *(const bf16x8*)kp, k1 = *(const bf16x8*)(kp + 32);
                f32x4 a = {0.f, 0.f, 0.f, 0.f};
                a = __builtin_amdgcn_mfma_f32_16x16x32_bf16(k0, aq0, a, 0, 0, 0); a = __builtin_amdgcn_mfma_f32_16x16x32_bf16(k1, aq1, a, 0, 0, 0); sc[j] = a; }
            const int c = c0 + n16, cs = min(max(c - 8, 0), 48);
            float mx = -1e30f;
#pragma unroll
            for (int j = 0; j < 16; ++j) { const int kr = j >> 1; const int brow = (h * 15 + (rs + kr - r + 7)) * 31;
#pragma unroll
                for (int i = 0; i < 4; ++i) { const int kc = kc0 + (j & 1) * 16 + 4 * g4 + i; const bool valid = (kc >= cs) && (kc < cs + 16);
                    const int bi = valid ? (brow + kc - c + 15) : 0;
                    const float s = valid ? (sc[j][i] * 0.125f + rpbl[bi]) * LOG2E : -1e30f; sc[j][i] = s; mx = __builtin_fmaxf(mx, s); } }
            mx = __builtin_fmaxf(mx, __shfl_xor(mx, 16)); mx = __builtin_fmaxf(mx, __shfl_xor(mx, 32));
            float sum = 0.f;
#pragma unroll
            for (int j = 0; j < 16; ++j)
#pragma unroll
                for (int i = 0; i < 4; ++i) { const float p = __builtin_amdgcn_exp2f(sc[j][i] - mx); sc[j][i] = p; sum += p; }
            sum += __shfl_xor(sum, 16); sum += __shfl_xor(sum, 32);
            const float linv = 1.f / sum;
            f32x4 oacc[4];
#pragma unroll
            for (int nt = 0; nt < 4; ++nt) oacc[nt] = (f32x4){0.f, 0.f, 0.f, 0.f};
#pragma unroll
            for (int kk = 0; kk < 8; ++kk) {
                u32x4 pw; pw.x = cvt_pk_bf16(sc[2 * kk][0], sc[2 * kk][1]); pw.y = cvt_pk_bf16(sc[2 * kk][2], sc[2 * kk][3]);
                pw.z = cvt_pk_bf16(sc[2 * kk + 1][0], sc[2 * kk + 1][1]); pw.w = cvt_pk_bf16(sc[2 * kk + 1][2], sc[2 * kk + 1][3]);
                const bf16x8 pf = __builtin_bit_cast(bf16x8, pw);
                const size_t tk0 = (size_t)tb + (rs + kk) * 64 + kc0 + 4 * g4;
#pragma unroll
                for (int nt = 0; nt < 4; ++nt) { const bf16_t* vp = VT + (size_t)(h * 64 + nt * 16 + n16) * T + tk0;
                    const u32x2 v0 = *(const u32x2*)vp, v1 = *(const u32x2*)(vp + 16);
                    const u32x4 vv = {v0.x, v0.y, v1.x, v1.y};
                    oacc[nt] = __builtin_amdgcn_mfma_f32_16x16x32_bf16(__builtin_bit_cast(bf16x8, vv), pf, oacc[nt], 0, 0, 0); }
            }
            bf16_t* op = OB + (size_t)(t0 + n16) * 512 + h * 64 + 4 * g4;
#pragma unroll
            for (int nt = 0; nt < 4; ++nt) { u32x2 w; w.x = cvt_pk_bf16(oacc[nt][0] * linv, oacc[nt][1] * linv); w.y = cvt_pk_bf16(oacc[nt][2] * linv, oacc[nt][3] * linv); *(u32x2*)(op + nt * 16) = w; }
        }
        __syncthreads();
    }
    SEAM(2);
    if (IN(3)) {
        { pg8::Gemm g{CQKV, WQB, T, 768, QL, 1024, QL}; pg8::StaticOrder S; S.init(T, 768, G, bx); pg8::EpiQ E{Qb, ROPE_T, C2_MLA}; pg8::gemm_phase(lds, g, S, E); }
        { pg8::Gemm g{CQKV + 768, WKVB, T, 1024, KVL, 1024, KVL}; pg8::StaticOrder S; S.init(T, 1024, G, bx); pg8::EpiPlain E{KV, 1024, 1.f}; pg8::gemm_phase(lds, g, S, E); }
        { pg8::Gemm g{OB, WBRB, T, 1024, 512, 512, 512}; pg8::StaticOrder S; S.init(T, 1024, G, bx); pg8::EpiGateB E{MB, GATES}; pg8::gemm_phase(lds, g, S, E); }
    }
    SEAM(3);
    if (IN(4)) {
        LAS char* shm = (LAS char*)lds;
        if (G == 256) {
            for (int i = 0; i < 8; ++i) { const int bh = (vcu >> 4) + 16 * i, b = bh >> 3, h = bh & 7, qb = vcu & 15; mla::attn_unit(b * 4096, 64, h, qb * 256, Qb, KV, KPE, OA, shm); }
            for (int i = 0; i < 2; ++i) { const int h = vcu >> 5, qb = (vcu & 31) + 32 * i; mla::attn_unit(TP, 256, h, qb * 256, Qb, KV, KPE, OA, shm); }
        } else {
            for (int uix = bx; uix < 2048 + 512; uix += G) {
                if (uix < 2048) { const int bh = uix >> 4, qb = uix & 15; mla::attn_unit((bh >> 3) * 4096, 64, bh & 7, qb * 256, Qb, KV, KPE, OA, shm); }
                else { const int v = uix - 2048; mla::attn_unit(TP, 256, v >> 6, (v & 63) * 256, Qb, KV, KPE, OA, shm); }
            }
        }
    }
    SEAM(4);
    if (IN(5)) { pg8::Gemm g{OA, WBRA, T, 1024, 512, 512, 512}; pg8::StaticOrder S; S.init(T, 1024, G, bx); pg8::EpiMerge E{MG, GATES, MB}; pg8::gemm_phase(lds, g, S, E); }
    SEAM(5);
    if (IN(6)) { pg8::Gemm g{MG, WO, T, 1024, DM, DM, DM}; pg8::StaticOrder S; S.init(T, 1024, G, bx); pg8::EpiResid E{xp, xs, out}; pg8::gemm_phase(lds, g, S, E); }
    SEAM(6);
    if (IN(7)) { for (int m = gw; m < T; m += NGW) rms_row_bf16(out + (size_t)m * DM, norm_ffn, XN + (size_t)m * DM, lane); }
    SEAM(7);
    if (IN(8)) { pg8::Gemm g{XN, WUP + (size_t)DFF * DM, T, FA, DM, DM, DM}; pg8::StaticOrder S; S.init(T, FA, G, bx); pg8::EpiPlain E{GB, FA, 1.f}; pg8::gemm_phase(lds, g, S, E); }
    SEAM(8);
    if (IN(9)) { pg8::Gemm g{XN, WUP, T, FA, DM, DM, DM}; pg8::StaticOrder S; S.init(T, FA, G, bx); pg8::EpiConv E{ACT, GB, FA, conv_w, conv_b, 0}; pg8::gemm_phase(lds, g, S, E); }
    SEAM(9);
    if (IN(10)) {
        { pg8::Gemm g{ACT, WDN, T, 1024, FA, FA, DFF}; pg8::StaticOrder S; S.init(T, 1024, G, bx); pg8::EpiResid E{nullptr, nullptr, out}; pg8::gemm_phase(lds, g, S, E); }
    }
    SEAM(10);
    if (IN(11)) { pg8::Gemm g{XN, WUP + (size_t)(DFF + FA) * DM, T, FB, DM, DM, DM}; pg8::StaticOrder S; S.init(T, FB, G, bx); pg8::EpiPlain E{GB, FB, 1.f}; pg8::gemm_phase(lds, g, S, E); }
    SEAM(11);
    if (IN(12)) { pg8::Gemm g{XN, WUP + (size_t)FA * DM, T, FB, DM, DM, DM}; pg8::StaticOrder S; S.init(T, FB, G, bx); pg8::EpiConv E{ACT, GB, FB, conv_w, conv_b, FA}; pg8::gemm_phase(lds, g, S, E); }
    SEAM(12);
    if (IN(13)) {
        { pg8::Gemm g{ACT, WDN + FA, T, 1024, FB, FB, DFF}; pg8::StaticOrder S; S.init(T, 1024, G, bx); pg8::EpiResid E{nullptr, nullptr, out}; pg8::gemm_phase(lds, g, S, E); }
    }
    SEAM(13);
    if (IN(14)) {
        for (int m = gw; m < T; m += NGW) {
            f32x4* xr = (f32x4*)(out + (size_t)m * DM) + lane; const f32x4* gr = (const f32x4*)norm_final + lane;
            f32x4 v[4]; float s = 0.f;
#pragma unroll
            for (int j = 0; j < 4; ++j) { v[j] = xr[64 * j]; s += (v[j].x * v[j].x + v[j].y * v[j].y) + (v[j].z * v[j].z + v[j].w * v[j].w); }
            const float rstd = 1.f / sqrtf(wave_sum(s) * (1.f / DM) + EPS);
#pragma unroll
            for (int j = 0; j < 4; ++j) { const f32x4 g = gr[64 * j]; xr[64 * j] = (f32x4){v[j].x * rstd * g.x, v[j].y * rstd * g.y, v[j].z * rstd * g.z, v[j].w * rstd * g.w}; }
        }
    }
#undef IN
#undef SEAM
}

extern "C" void kernel_launch(void* const* d_in, const int* in_sizes, int n_in, void* d_out, int out_size, void* d_ws, size_t ws_size, hipStream_t stream) {
    static int grid = 0;
    if (grid == 0) {
        if (n_in != 19 || out_size != T * DM || ws_size < WS_END) { fprintf(stderr, "kernel_launch: unexpected shapes (n_in %d, out %d, ws %zu)\n", n_in, out_size, ws_size); grid = -1; return; }
        int dev = 0, cus = 0, per_cu = 0;
        hipGetDevice(&dev); hipDeviceGetAttribute(&cus, hipDeviceAttributeMultiprocessorCount, dev);
        if (hipFuncSetAttribute((const void*)mega_fwd, hipFuncAttributeMaxDynamicSharedMemorySize, LDS_BYTES) != hipSuccess) { fprintf(stderr, "kernel_launch: hipFuncSetAttribute failed\n"); grid = -1; return; }
        if (hipOccupancyMaxActiveBlocksPerMultiprocessor(&per_cu, (const void*)mega_fwd, 512, LDS_BYTES) != hipSuccess || per_cu < 1) { fprintf(stderr, "kernel_launch: occupancy query says %d\n", per_cu); per_cu = 1; }
        (void)hipGetLastError();
        grid = cus * per_cu;
        fprintf(stderr, "kernel_launch: grid %d (cus %d x %d)\n", grid, cus, per_cu);
    }
    if (grid < 0) return;
    Args a{};
    for (int i = 0; i < 19; ++i) a.in[i] = (const float*)d_in[i];
    a.out = (float*)d_out; a.ws = (unsigned char*)d_ws;
#if MK_N_LAUNCHES == 1
    a.ph_lo = 0; a.ph_hi = NPH + 1;
    void* kargs[] = {&a};
    hipError_t e = hipLaunchCooperativeKernel((const void*)mega_fwd, dim3(grid), dim3(512), kargs, LDS_BYTES, stream);
    if (e != hipSuccess) fprintf(stderr, "cooperative launch failed: %s (grid %d)\n", hipGetErrorString(e), grid);
#else
    for (int p = 0; p <= NPH; ++p) { a.ph_lo = p; a.ph_hi = p + 1; hipLaunchKernelGGL(mega_fwd, dim3(grid), dim3(512), LDS_BYTES, stream, a); }
#endif
}
```

```cpp
#include <hip/hip_runtime.h>
#include <hip/hip_cooperative_groups.h>
#include <hip/hip_bf16.h>
#include <cstdio>
#include <cstdint>
namespace cg = cooperative_groups;

#ifndef MK_N_LAUNCHES
#define MK_N_LAUNCHES 1
#endif

#ifndef PROBE_DUP
#define PROBE_DUP -1
#endif
#define REPS(k) ((PROBE_DUP == (k)) ? 2 : 1)
#define LAS __attribute__((address_space(3)))
typedef unsigned short bf16_t;
typedef short bf16x8 __attribute__((ext_vector_type(8)));
typedef short s16x4 __attribute__((ext_vector_type(4)));
typedef float f32x4 __attribute__((ext_vector_type(4)));
typedef float f32x16 __attribute__((ext_vector_type(16)));
typedef float f32x2 __attribute__((ext_vector_type(2)));
typedef unsigned u32x4 __attribute__((ext_vector_type(4)));
typedef unsigned u32x2 __attribute__((ext_vector_type(2)));

constexpr int TP = 65536, TS = 16384, T = TP + TS;
constexpr int DM = 1024, QL = 768, KVL = 256, ROPE = 32, NAW = 512, DFF = 2816;
constexpr int IN_COLS = 4640, IN_PAD = 4864;
constexpr int NPH = 14;
constexpr float EPS = 1e-6f;
constexpr float LOG2E = 1.4426950408889634f;
constexpr float C2_MLA = 0.10206207261596577f * LOG2E;
constexpr int FA = 2048, FB = 768;

constexpr size_t MiB = 1u << 20;
constexpr size_t WS_ROPE = 0;
constexpr size_t WS_WIN = 2 * MiB;
constexpr size_t WS_WQB = 12 * MiB;
constexpr size_t WS_WKVB = 14 * MiB;
constexpr size_t WS_WBRA = 15 * MiB;
constexpr size_t WS_WBRB = 16 * MiB;
constexpr size_t WS_WO = 17 * MiB;
constexpr size_t WS_WUP = 19 * MiB;
constexpr size_t WS_WDN = 30 * MiB;
constexpr size_t WS_XN = 40 * MiB;
constexpr size_t WS_KV = 40 * MiB;
constexpr size_t WS_CQKV = 200 * MiB;
constexpr size_t WS_MG = 200 * MiB;
constexpr size_t WS_NAQK = 360 * MiB;
constexpr size_t WS_VT = 520 * MiB;
constexpr size_t WS_Q = 360 * MiB;
constexpr size_t WS_OA = 480 * MiB;
constexpr size_t WS_OB = 600 * MiB;
constexpr size_t WS_MB = 680 * MiB;
constexpr size_t WS_KPE = 840 * MiB;
constexpr size_t WS_G = 200 * MiB;
constexpr size_t WS_ACT = 520 * MiB;
constexpr size_t WS_CTL = 848 * MiB;
constexpr size_t WS_END = 849 * MiB;

constexpr int RING_BYTES = 131072;
constexpr int LDS_BYTES = 147456;

__device__ __forceinline__ unsigned cvt_pk_bf16(float lo, float hi) {
    f32x2 v = {lo, hi}; typedef __bf16 bf2 __attribute__((ext_vector_type(2)));
    bf2 b = __builtin_convertvector(v, bf2); return __builtin_bit_cast(unsigned, b);
}
__device__ __forceinline__ float bf_lo(unsigned w) { return __uint_as_float(w << 16); }
__device__ __forceinline__ float bf_hi(unsigned w) { return __uint_as_float(w & 0xffff0000u); }
__device__ __forceinline__ void unpack8(u32x4 w, float (&f)[8]) {
    f[0] = bf_lo(w.x); f[1] = bf_hi(w.x); f[2] = bf_lo(w.y); f[3] = bf_hi(w.y);
    f[4] = bf_lo(w.z); f[5] = bf_hi(w.z); f[6] = bf_lo(w.w); f[7] = bf_hi(w.w);
}
__device__ __forceinline__ u32x4 pack8(const float (&f)[8]) {
    u32x4 w; w.x = cvt_pk_bf16(f[0], f[1]); w.y = cvt_pk_bf16(f[2], f[3]); w.z = cvt_pk_bf16(f[4], f[5]); w.w = cvt_pk_bf16(f[6], f[7]); return w;
}
__device__ __forceinline__ float wave_sum(float v) {
#pragma unroll
    for (int o = 1; o < 64; o <<= 1) v += __shfl_xor(v, o);
    return v;
}
__device__ __forceinline__ int seq_pos(int t) { return t < TP ? (t & 4095) : (t - TP); }
__device__ __forceinline__ float sigmoidf_(float x) { return 1.f / (1.f + __expf(-x)); }

namespace pg8 {
constexpr int BM = 256, BK = 64, HALF = 128, HTB = HALF * BK * 2, STAGE_BYTES = 8 * HTB, NXCD = 8, WGM = 8;
__host__ __device__ __forceinline__ int lds_byte(int r, int c) { const int st = (r >> 4) * 2 + (c >> 5), rr = r & 15, cc = c & 31, ob = rr * 64 + cc * 2; return st * 1024 + (ob ^ (((ob >> 9) & 1) << 5)); }
__host__ __device__ __forceinline__ void stage_rc(int b, int& R, int& C) { const int st = b / 1024, sb = b % 1024, swz = sb ^ (((sb >> 9) & 1) << 5); R = (st >> 1) * 16 + swz / 64; C = (st & 1) * 32 + (swz % 64) / 2; }
__host__ __device__ __forceinline__ int perm32(int rho) { const int n = rho >> 4, i = rho & 15; return 8 * (i >> 2) + 4 * n + (i & 3); }

struct Unit { int pm, pn; };
struct Gemm { const bf16_t* A; const bf16_t* Bt; int M, N, K, lda, ldb; };

struct StaticOrder {
    int nM, nN, nwg, G, c, reps;
    __device__ void init(int M, int N, int G_, int c_, int reps_ = 1) { nM = M / BM; nN = N / BM; nwg = nM * nN; G = G_; c = c_; reps = reps_; }
    __device__ bool next(int i, Unit& u) const {
        const long L = (long)i * G + c; if (L >= (long)nwg * reps) return false;
        int wgid = (int)(L % nwg); { const int q = nwg / NXCD, r = nwg % NXCD, xcd = wgid % NXCD, off = wgid / NXCD; wgid = (xcd < r ? xcd * (q + 1) : r * (q + 1) + (xcd - r) * q) + off; }
        const int nig = WGM * nN, gid = wgid / nig, fm = gid * WGM, gsz = (nM - fm) < WGM ? (nM - fm) : WGM;
        u.pm = fm + ((wgid % nig) % gsz); u.pn = (wgid % nig) / gsz; return true;
    }
};

template <class Epi>
__device__ __forceinline__ void gemm_phase(LAS unsigned char* lds, const Gemm g, const StaticOrder& S, const Epi& E) {
    const int tid = threadIdx.x, wid = __builtin_amdgcn_readfirstlane(tid >> 6), lane = tid & 63, wr = wid >> 2, wc = wid & 3, fr = lane & 15, fq = lane >> 4;
    const int K = g.K, nt = K / BK;
    unsigned voffA[2], voffB[2];
#pragma unroll
    for (int i = 0; i < 2; ++i) { int R, C; stage_rc(tid * 16 + i * 8192, R, C); const int Rb = (R & ~31) + perm32(R & 31);
        voffA[i] = (unsigned)(R * g.lda + C) * 2u; voffB[i] = (unsigned)(Rb * g.ldb + C) * 2u; }
    const size_t kstep = (size_t)(BK * 2);
    const size_t hstepA = (size_t)HALF * g.lda * 2, hstepB = (size_t)HALF * g.ldb * 2;
    const size_t tstepA = 2 * hstepA, tstepB = 2 * hstepB;
    const unsigned ldsw = (unsigned)wid * 1024u;
    const int aoff = lds_byte(wr * 64 + fr, fq * 8), boff = lds_byte(wc * 32 + fr, fq * 8);
#define PG8_SA(b, h) (((b) * 2 + (h)) * HTB)
#define PG8_SB(b, h) ((4 + (b) * 2 + (h)) * HTB)
#define PG8_STAGE(bufoff, gbase, voff) do { _Pragma("unroll") for (int _i = 0; _i < 2; ++_i) \
        __builtin_amdgcn_global_load_lds((const unsigned*)((const char*)(gbase) + (voff)[_i]), (LAS unsigned*)(lds + (bufoff) + ldsw + _i * 8192), 16, 0, 0); } while (0)
#define PG8_LDA(dst, b, h) do { _Pragma("unroll") for (int m = 0; m < 4; ++m) _Pragma("unroll") for (int k = 0; k < 2; ++k) dst[m][k] = *(const LAS bf16x8*)(lds + PG8_SA(b, h) + aoff + m * 2048 + k * 1024); } while (0)
#define PG8_LDB(dst, b, h) do { _Pragma("unroll") for (int n = 0; n < 2; ++n) _Pragma("unroll") for (int k = 0; k < 2; ++k) dst[n][k] = *(const LAS bf16x8*)(lds + PG8_SB(b, h) + boff + n * 2048 + k * 1024); } while (0)
#define PG8_MMA(ai, bj, At, Bt) do { __builtin_amdgcn_s_setprio(1); _Pragma("unroll") for (int m = 0; m < 4; ++m) _Pragma("unroll") for (int n = 0; n < 2; ++n) _Pragma("unroll") for (int k = 0; k < 2; ++k) \
        acc[ai][bj][m][n] = __builtin_amdgcn_mfma_f32_16x16x32_bf16(Bt[n][k], At[m][k], acc[ai][bj][m][n], 0, 0, 0); __builtin_amdgcn_s_setprio(0); } while (0)
#define PG8_WAIT_V(n) asm volatile("s_waitcnt vmcnt(" #n ")" ::: "memory")
#define PG8_WAIT_L(n) asm volatile("s_waitcnt lgkmcnt(" #n ")" ::: "memory")
#define PG8_BAR __builtin_amdgcn_s_barrier()
#define PG8_SCHED __builtin_amdgcn_sched_barrier(0)
    Unit cur, nxt; int ui = 0;
    if (!S.next(0, cur)) return;
    f32x4 acc[2][2][4][2];
#pragma unroll
    for (int a = 0; a < 2; ++a)
#pragma unroll
        for (int b = 0; b < 2; ++b)
#pragma unroll
            for (int m = 0; m < 4; ++m)
#pragma unroll
                for (int n = 0; n < 2; ++n) acc[a][b][m][n] = (f32x4){0.f, 0.f, 0.f, 0.f};
    bf16x8 At[4][2], B0[2][2], B1[2][2];
    const char* cA = (const char*)g.A + (size_t)cur.pm * tstepA; const char* cB = (const char*)g.Bt + (size_t)cur.pn * tstepB;
    PG8_STAGE(PG8_SB(0, 0), cB, voffB); PG8_STAGE(PG8_SB(0, 1), cB + hstepB, voffB); PG8_STAGE(PG8_SA(0, 0), cA, voffA); PG8_STAGE(PG8_SA(0, 1), cA + hstepA, voffA);
    if (wr == 1) PG8_BAR;
    PG8_WAIT_V(2); PG8_BAR;
    PG8_STAGE(PG8_SB(1, 0), cB + kstep, voffB); PG8_STAGE(PG8_SA(1, 0), cA + kstep, voffA); PG8_STAGE(PG8_SB(1, 1), cB + hstepB + kstep, voffB);
    PG8_WAIT_V(6); PG8_BAR;
    for (;;) {
        const bool has_next = S.next(ui + 1, nxt);
        const char* nA = has_next ? (const char*)g.A + (size_t)nxt.pm * tstepA : cA; const char* nB = has_next ? (const char*)g.Bt + (size_t)nxt.pn * tstepB : cB;
        for (int t = 0; t < nt; t += 2) {
            const bool last = (t == nt - 2);
            const char* a1 = cA + (size_t)(t + 1) * kstep;
            const char* a2 = last ? nA : cA + (size_t)(t + 2) * kstep; const char* b2 = last ? nB : cB + (size_t)(t + 2) * kstep;
            const char* a3 = a2 + kstep; const char* b3 = b2 + kstep;
            PG8_LDB(B0, 0, 0); PG8_LDB(B1, 0, 1); PG8_SCHED; PG8_LDA(At, 0, 0); PG8_STAGE(PG8_SA(1, 1), a1 + hstepA, voffA);
            PG8_WAIT_V(8); PG8_WAIT_L(0); PG8_BAR; PG8_MMA(0, 0, At, B0); PG8_MMA(0, 1, At, B1); PG8_BAR; PG8_SCHED;
            PG8_LDA(At, 0, 1); PG8_STAGE(PG8_SB(0, 0), b2, voffB); PG8_STAGE(PG8_SB(0, 1), b2 + hstepB, voffB); PG8_STAGE(PG8_SA(0, 0), a2, voffA);
            PG8_WAIT_V(8); PG8_WAIT_L(0); PG8_BAR; PG8_MMA(1, 0, At, B0); PG8_MMA(1, 1, At, B1); PG8_BAR; PG8_SCHED;
            PG8_LDB(B0, 1, 0); PG8_LDB(B1, 1, 1); PG8_SCHED; PG8_LDA(At, 1, 0); PG8_STAGE(PG8_SA(0, 1), a2 + hstepA, voffA);
            PG8_WAIT_V(8); PG8_WAIT_L(0); PG8_BAR; PG8_MMA(0, 0, At, B0); PG8_MMA(0, 1, At, B1); PG8_BAR; PG8_SCHED;
            PG8_LDA(At, 1, 1); PG8_STAGE(PG8_SB(1, 0), b3, voffB); PG8_STAGE(PG8_SB(1, 1), b3 + hstepB, voffB); PG8_STAGE(PG8_SA(1, 0), a3, voffA);
            PG8_WAIT_V(8); PG8_WAIT_L(0); PG8_BAR; PG8_MMA(1, 0, At, B0); PG8_MMA(1, 1, At, B1); PG8_BAR; PG8_SCHED;
        }
        if (wr == 0) PG8_BAR;
        E(acc, cur, wr, wc, fr, fq);
        if (!has_next) break;
#pragma unroll
        for (int a = 0; a < 2; ++a)
#pragma unroll
            for (int b = 0; b < 2; ++b)
#pragma unroll
                for (int m = 0; m < 4; ++m)
#pragma unroll
                    for (int n = 0; n < 2; ++n) acc[a][b][m][n] = (f32x4){0.f, 0.f, 0.f, 0.f};
        cur = nxt; cA = nA; cB = nB; ++ui;
        if (wr == 1) PG8_BAR;
    }
    PG8_WAIT_V(0);
    PG8_BAR;
#undef PG8_SA
#undef PG8_SB
#undef PG8_STAGE
#undef PG8_LDA
#undef PG8_LDB
#undef PG8_MMA
#undef PG8_WAIT_V
#undef PG8_WAIT_L
#undef PG8_BAR
#undef PG8_SCHED
}

#define EPI_LOOP_BEGIN \
    _Pragma("unroll") for (int ai = 0; ai < 2; ++ai) _Pragma("unroll") for (int m = 0; m < 4; ++m) { const int row = u.pm * BM + ai * HALF + wr * 64 + m * 16 + fr; \
    _Pragma("unroll") for (int bj = 0; bj < 2; ++bj) { const int tcol = bj * HALF + wc * 32 + 8 * fq; \
        float v[8]; { const f32x4 a0 = acc[ai][bj][m][0], a1 = acc[ai][bj][m][1]; v[0] = a0[0]; v[1] = a0[1]; v[2] = a0[2]; v[3] = a0[3]; v[4] = a1[0]; v[5] = a1[1]; v[6] = a1[2]; v[7] = a1[3]; }
#define EPI_LOOP_END } }

struct EpiPlain {
    bf16_t* O; int ldc; float scale;
    __device__ __forceinline__ void operator()(const f32x4 (&acc)[2][2][4][2], const Unit& u, int wr, int wc, int fr, int fq) const {
        EPI_LOOP_BEGIN
#pragma unroll
            for (int j = 0; j < 8; ++j) v[j] *= scale;
            *(u32x4*)(O + (size_t)row * ldc + u.pn * BM + tcol) = pack8(v);
        EPI_LOOP_END
    }
};
struct EpiIn {
    bf16_t *cqkv, *naqk, *vt, *gates, *kpe; const float* bgate;
    __device__ __forceinline__ void operator()(const f32x4 (&acc)[2][2][4][2], const Unit& u, int wr, int wc, int fr, int fq) const {
        const int pn = u.pn;
        if (pn < 8) {
            bf16_t* O = pn < 4 ? cqkv : naqk; const int cb = (pn & 3) * BM;
            EPI_LOOP_BEGIN
                *(u32x4*)(O + (size_t)row * 1024 + cb + tcol) = pack8(v);
            EPI_LOOP_END
        } else if (pn < 10) {
            const int cb = (pn - 8) * BM;
            EPI_LOOP_BEGIN
#pragma unroll
                for (int j = 0; j < 8; j += 2) { const unsigned w = cvt_pk_bf16(v[j], v[j + 1]);
                    vt[(size_t)(cb + tcol + j) * T + row] = (bf16_t)(w & 0xffffu); vt[(size_t)(cb + tcol + j + 1) * T + row] = (bf16_t)(w >> 16); }
            EPI_LOOP_END
        } else if (pn < 18) {
            const int cb = (pn - 10) * BM;
            EPI_LOOP_BEGIN
                const f32x4 b0 = *(const f32x4*)(bgate + cb + tcol), b1 = *(const f32x4*)(bgate + cb + tcol + 4);
                v[0] = sigmoidf_(v[0] + b0[0]); v[1] = sigmoidf_(v[1] + b0[1]); v[2] = sigmoidf_(v[2] + b0[2]); v[3] = sigmoidf_(v[3] + b0[3]);
                v[4] = sigmoidf_(v[4] + b1[0]); v[5] = sigmoidf_(v[5] + b1[1]); v[6] = sigmoidf_(v[6] + b1[2]); v[7] = sigmoidf_(v[7] + b1[3]);
                *(u32x4*)(gates + (size_t)row * 2048 + cb + tcol) = pack8(v);
            EPI_LOOP_END
        } else {
            if (wc == 0) {
                EPI_LOOP_BEGIN
                    if (bj == 0) *(u32x4*)(kpe + (size_t)row * 32 + tcol) = pack8(v);
                EPI_LOOP_END
            }
        }
    }
};
struct EpiQ {
    bf16_t* Q; const f32x2* rope; float scale;
    __device__ __forceinline__ void operator()(const f32x4 (&acc)[2][2][4][2], const Unit& u, int wr, int wc, int fr, int fq) const {
        if (u.pn < 2) {
            EPI_LOOP_BEGIN
#pragma unroll
                for (int j = 0; j < 8; ++j) v[j] *= scale;
                *(u32x4*)(Q + (size_t)row * 768 + u.pn * BM + tcol) = pack8(v);
            EPI_LOOP_END
        } else {
            EPI_LOOP_BEGIN
                const f32x2* rp = rope + (size_t)seq_pos(row) * 16 + (fq & 1) * 8;
#pragma unroll
                for (int j = 0; j < 8; ++j) { const float other = __shfl_xor(v[j], 32); const f32x2 cs = rp[j];
                    const float x1 = (fq < 2) ? v[j] : other, x2 = (fq < 2) ? other : v[j];
                    v[j] = ((fq < 2) ? (x1 * cs.x - x2 * cs.y) : (x1 * cs.y + x2 * cs.x)) * scale; }
                *(u32x4*)(Q + (size_t)row * 768 + 512 + tcol) = pack8(v);
            EPI_LOOP_END
        }
    }
};
struct EpiGateB {
    bf16_t* O; const bf16_t* gates;
    __device__ __forceinline__ void operator()(const f32x4 (&acc)[2][2][4][2], const Unit& u, int wr, int wc, int fr, int fq) const {
        EPI_LOOP_BEGIN
            const int col = u.pn * BM + tcol; float g[8]; unpack8(*(const u32x4*)(gates + (size_t)row * 2048 + 1024 + col), g);
#pragma unroll
            for (int j = 0; j < 8; ++j) v[j] *= g[j];
            *(u32x4*)(O + (size_t)row * 1024 + col) = pack8(v);
        EPI_LOOP_END
    }
};
struct EpiMerge {
    bf16_t* O; const bf16_t* gates; const bf16_t* mb;
    __device__ __forceinline__ void operator()(const f32x4 (&acc)[2][2][4][2], const Unit& u, int wr, int wc, int fr, int fq) const {
        EPI_LOOP_BEGIN
            const int col = u.pn * BM + tcol; float g[8], b[8];
            unpack8(*(const u32x4*)(gates + (size_t)row * 2048 + col), g); unpack8(*(const u32x4*)(mb + (size_t)row * 1024 + col), b);
#pragma unroll
            for (int j = 0; j < 8; ++j) v[j] = v[j] * g[j] + b[j];
            *(u32x4*)(O + (size_t)row * 1024 + col) = pack8(v);
        EPI_LOOP_END
    }
};
struct EpiResid {
    const float* xp; const float* xs; float* out;
    __device__ __forceinline__ void operator()(const f32x4 (&acc)[2][2][4][2], const Unit& u, int wr, int wc, int fr, int fq) const {
        EPI_LOOP_BEGIN
            const int col = u.pn * BM + tcol;
            const float* bp = xp ? (row < TP ? xp + (size_t)row * DM : xs + (size_t)(row - TP) * DM) : out + (size_t)row * DM;
            const f32x4 b0 = *(const f32x4*)(bp + col), b1 = *(const f32x4*)(bp + col + 4);
            f32x4 o0 = {v[0] + b0[0], v[1] + b0[1], v[2] + b0[2], v[3] + b0[3]}, o1 = {v[4] + b1[0], v[5] + b1[1], v[6] + b1[2], v[7] + b1[3]};
            *(f32x4*)(out + (size_t)row * DM + col) = o0; *(f32x4*)(out + (size_t)row * DM + col + 4) = o1;
        EPI_LOOP_END
    }
};
struct EpiConv {
    bf16_t* O; const bf16_t* G; int ldg; const float* cw; const float* cb; int ch_off;
    __device__ __forceinline__ void operator()(const f32x4 (&acc)[2][2][4][2], const Unit& u, int wr, int wc, int fr, int fq) const {
#pragma unroll
        for (int bj = 0; bj < 2; ++bj) {
            const int lc = u.pn * BM + bj * HALF + wc * 32 + 8 * fq, ch = ch_off + lc;
            float w0[8], w1[8], w2[8], bb[8];
#pragma unroll
            for (int j = 0; j < 8; j += 4) { const f32x4 a = *(const f32x4*)(cw + ch + j), b = *(const f32x4*)(cw + DFF + ch + j), c = *(const f32x4*)(cw + 2 * DFF + ch + j), d = *(const f32x4*)(cb + ch + j);
#pragma unroll
                for (int i = 0; i < 4; ++i) { w0[j + i] = a[i]; w1[j + i] = b[i]; w2[j + i] = c[i]; bb[j + i] = d[i]; } }
#pragma unroll
            for (int ai = 0; ai < 2; ++ai)
#pragma unroll
                for (int m = 0; m < 4; ++m) {
                    const int row = u.pm * BM + ai * HALF + wr * 64 + m * 16 + fr;
                    const bool hasl = row < TP ? ((row & 4095) != 0) : (row != TP);
                    const bool hasr = row < TP ? ((row & 4095) != 4095) : (row != T - 1);
                    const bf16_t* gp = G + (size_t)row * ldg + lc;
                    float gm[8], gc[8], gn[8];
                    unpack8(*(const u32x4*)gp, gc);
                    if (hasl) unpack8(*(const u32x4*)(gp - ldg), gm); else { _Pragma("unroll") for (int j = 0; j < 8; ++j) gm[j] = 0.f; }
                    if (hasr) unpack8(*(const u32x4*)(gp + ldg), gn); else { _Pragma("unroll") for (int j = 0; j < 8; ++j) gn[j] = 0.f; }
                    const f32x4 a0 = acc[ai][bj][m][0], a1 = acc[ai][bj][m][1];
                    float uu[8] = {a0[0], a0[1], a0[2], a0[3], a1[0], a1[1], a1[2], a1[3]}; float o[8];
#pragma unroll
                    for (int j = 0; j < 8; ++j) { const float gg = gm[j] * w0[j] + gc[j] * w1[j] + gn[j] * w2[j] + bb[j]; o[j] = gg * sigmoidf_(gg) * uu[j]; }
                    *(u32x4*)(O + (size_t)row * ldg + lc) = pack8(o);
                }
        }
    }
};
}

namespace mla {
constexpr int NW = 8, QBLK = 32, QB = 256, KVBLK = 64;
constexpr int NSLOT = 3, KSLOT = 12288, VSLOT = 8192;
constexpr int LDS_K = 0, LDS_V = NSLOT * KSLOT, LDS_WS = LDS_V + NSLOT * VSLOT, LDS_OST = LDS_WS + NW * 64 * 4, LDS_TOTAL = LDS_OST + NW * 4096;
static_assert(LDS_TOTAL <= RING_BYTES, "mla lds");
typedef LAS const char* lds_cptr;
__device__ __forceinline__ int crow(int r, int hi) { return (r & 3) + 8 * (r >> 2) + 4 * hi; }
__device__ __forceinline__ void glds16(const void* gsrc, unsigned lds_dst) { unsigned keep;
    asm volatile("s_mov_b32 %0, m0\n\ts_mov_b32 m0, %2\n\ts_nop 0\n\tglobal_load_lds_dwordx4 %1, off\n\ts_mov_b32 m0, %0" : "=&s"(keep) : "v"(gsrc), "s"(lds_dst) : "memory"); }
#define MLA_WAIT_BAR(N) asm volatile("s_waitcnt vmcnt(" #N ") lgkmcnt(0)\n\ts_barrier" ::: "memory")

__device__ __forceinline__ float rowmax32(const f32x16& p0, const f32x16& p1) {
    float a = __builtin_fmaxf(p0[0], p1[0]);
#pragma unroll
    for (int r = 1; r < 16; ++r) a = __builtin_fmaxf(a, __builtin_fmaxf(p0[r], p1[r]));
    auto rr = __builtin_amdgcn_permlane32_swap(__float_as_uint(a), __float_as_uint(a), false, false);
    return __builtin_fmaxf(__uint_as_float(rr[0]), __uint_as_float(rr[1]));
}
__device__ __forceinline__ void pv(f32x16* o, int vb, bf16x8 pa0, bf16x8 pa1, bf16x8 pa2, bf16x8 pa3) {
#pragma unroll
    for (int d0 = 0; d0 < 2; ++d0) { s16x4 lo[4], hi[4];
#pragma unroll
        for (int ks = 0; ks < 4; ++ks) {
            asm volatile("ds_read_b64_tr_b16 %0,%1 offset:%c2" : "=&v"(lo[ks]) : "v"(vb), "i"(d0 * 4096 + ks * 1024) : "memory");
            asm volatile("ds_read_b64_tr_b16 %0,%1 offset:%c2" : "=&v"(hi[ks]) : "v"(vb), "i"(d0 * 4096 + ks * 1024 + 512) : "memory"); }
        asm volatile("s_waitcnt lgkmcnt(0)" ::: "memory"); __builtin_amdgcn_sched_barrier(0);
#define MLA_PK(k) (bf16x8){lo[k][0], lo[k][1], lo[k][2], lo[k][3], hi[k][0], hi[k][1], hi[k][2], hi[k][3]}
        o[d0] = __builtin_amdgcn_mfma_f32_32x32x16_bf16(pa0, MLA_PK(0), o[d0], 0, 0, 0);
        o[d0] = __builtin_amdgcn_mfma_f32_32x32x16_bf16(pa1, MLA_PK(1), o[d0], 0, 0, 0);
        o[d0] = __builtin_amdgcn_mfma_f32_32x32x16_bf16(pa2, MLA_PK(2), o[d0], 0, 0, 0);
        o[d0] = __builtin_amdgcn_mfma_f32_32x32x16_bf16(pa3, MLA_PK(3), o[d0], 0, 0, 0);
#undef MLA_PK
    }
}

__device__ __forceinline__ void attn_unit(int tb, int NT, int h, int q0, const bf16_t* Q, const bf16_t* __restrict__ KV, const bf16_t* __restrict__ KPE, bf16_t* OA, LAS char* shm) {
    const int tid = threadIdx.x, lane = tid & 63, r32 = lane & 31, hi = lane >> 5; const int wid = __builtin_amdgcn_readfirstlane(tid >> 6);
    const unsigned lds0 = (unsigned)(uintptr_t)shm;
    LAS float* wsf = (LAS float*)(shm + LDS_WS) + wid * 64;
    asm volatile("s_waitcnt vmcnt(0)" ::: "memory");
    const bf16_t* Qw = Q + (size_t)(tb + q0 + wid * QBLK + r32) * 768;
    bf16x8 qr[6];
#pragma unroll
    for (int d0 = 0; d0 < 4; ++d0) qr[d0] = *(const bf16x8*)(Qw + h * 64 + d0 * 16 + hi * 8);
#pragma unroll
    for (int d0 = 0; d0 < 2; ++d0) qr[4 + d0] = *(const bf16x8*)(Qw + 512 + h * 32 + d0 * 16 + hi * 8);
    const bf16_t* ksrc = KV + (size_t)(tb + lane) * 1024 + h * 64 + wid * 8;
    const bf16_t* rsrc = KPE + (size_t)(tb + lane) * 32 + (wid & 3) * 8;
    const bf16_t* vsrc = KV + (size_t)(tb + 16 * (wid & 3) + (lane >> 2)) * 1024 + 512 + h * 64 + (wid >> 2) * 32 + (lane & 3) * 8;
    const unsigned kdst = lds0 + LDS_K + wid * 1024, rdst = lds0 + LDS_K + (8 + (wid & 3)) * 1024, vdst = lds0 + LDS_V + wid * 1024;
#define MLA_DMA(t, s) do { glds16(ksrc + (size_t)(t) * KVBLK * 1024, (unsigned)__builtin_amdgcn_readfirstlane(kdst + (s) * KSLOT)); \
        glds16(rsrc + (size_t)(t) * KVBLK * 32, (unsigned)__builtin_amdgcn_readfirstlane(rdst + (s) * KSLOT)); \
        glds16(vsrc + (size_t)(t) * KVBLK * 1024, (unsigned)__builtin_amdgcn_readfirstlane(vdst + (s) * VSLOT)); } while (0)
    const int vb0 = (int)(lds0 + LDS_V) + ((lane >> 4) & 1) * 32 + (lane & 3) * 8 + (4 * hi + ((lane & 15) >> 2)) * 64;
    const lds_cptr kp0 = (lds_cptr)shm + LDS_K + hi * 1024 + r32 * 16;
    MLA_DMA(0, 0); MLA_DMA(1, 1);
    float mhat = 0.f, l_reg = 0.f; f32x16 o[2]; o[0] = f32x16{}; o[1] = f32x16{}; f32x16 negm = f32x16{};
    int slot = 0;
    for (int t = 0; t < NT; ++t) {
        if (t + 1 < NT) { MLA_WAIT_BAR(3); } else { MLA_WAIT_BAR(0); }
        { const int s2 = (slot == 0) ? 2 : slot - 1; if (t + 2 < NT) MLA_DMA(t + 2, s2); }
        f32x16 p0, p1;
        { const lds_cptr kb = kp0 + slot * KSLOT;
#pragma unroll
          for (int d0 = 0; d0 < 6; ++d0) {
              const bf16x8 b0 = *(const LAS bf16x8*)(kb + d0 * 2048);
              const bf16x8 b1 = *(const LAS bf16x8*)(kb + d0 * 2048 + 512);
              if (d0 == 0) { p0 = __builtin_amdgcn_mfma_f32_32x32x16_bf16(b0, qr[0], negm, 0, 0, 0); p1 = __builtin_amdgcn_mfma_f32_32x32x16_bf16(b1, qr[0], negm, 0, 0, 0); }
              else { p0 = __builtin_amdgcn_mfma_f32_32x32x16_bf16(b0, qr[d0], p0, 0, 0, 0); p1 = __builtin_amdgcn_mfma_f32_32x32x16_bf16(b1, qr[d0], p1, 0, 0, 0); } } }
        const float rm = rowmax32(p0, p1);
        if (t == 0) {
            mhat = rm;
#pragma unroll
            for (int r = 0; r < 16; ++r) { p0[r] -= rm; p1[r] -= rm; negm[r] = -mhat; }
        } else if (__any(rm > 8.0f)) {
            const float dl = __builtin_fmaxf(rm, 0.f); mhat += dl;
#pragma unroll
            for (int r = 0; r < 16; ++r) { p0[r] -= dl; p1[r] -= dl; negm[r] = -mhat; }
            const float f = __builtin_amdgcn_exp2f(-dl); l_reg *= f;
            if (hi == 0) wsf[r32] = f;
            asm volatile("s_waitcnt lgkmcnt(0)" ::: "memory");
#pragma unroll
            for (int r = 0; r < 16; ++r) { const float fr_ = wsf[crow(r, hi)]; o[0][r] *= fr_; o[1][r] *= fr_; }
        }
        float sacc = 0.f;
#pragma unroll
        for (int r = 0; r < 16; ++r) { p0[r] = __builtin_amdgcn_exp2f(p0[r]); p1[r] = __builtin_amdgcn_exp2f(p1[r]); sacc += p0[r] + p1[r]; }
        l_reg += sacc;
        u32x4 pw0, pw1, pw2, pw3;
        pw0 = (u32x4){cvt_pk_bf16(p0[0], p0[1]), cvt_pk_bf16(p0[2], p0[3]), cvt_pk_bf16(p0[4], p0[5]), cvt_pk_bf16(p0[6], p0[7])};
        pw1 = (u32x4){cvt_pk_bf16(p0[8], p0[9]), cvt_pk_bf16(p0[10], p0[11]), cvt_pk_bf16(p0[12], p0[13]), cvt_pk_bf16(p0[14], p0[15])};
        pw2 = (u32x4){cvt_pk_bf16(p1[0], p1[1]), cvt_pk_bf16(p1[2], p1[3]), cvt_pk_bf16(p1[4], p1[5]), cvt_pk_bf16(p1[6], p1[7])};
        pw3 = (u32x4){cvt_pk_bf16(p1[8], p1[9]), cvt_pk_bf16(p1[10], p1[11]), cvt_pk_bf16(p1[12], p1[13]), cvt_pk_bf16(p1[14], p1[15])};
        pv(o, vb0 + slot * VSLOT, __builtin_bit_cast(bf16x8, pw0), __builtin_bit_cast(bf16x8, pw1), __builtin_bit_cast(bf16x8, pw2), __builtin_bit_cast(bf16x8, pw3));
        slot = (slot == 2) ? 0 : slot + 1;
    }
    { auto rr = __builtin_amdgcn_permlane32_swap(__float_as_uint(l_reg), __float_as_uint(l_reg), false, false); l_reg = __uint_as_float(rr[0]) + __uint_as_float(rr[1]); }
    if (hi == 0) wsf[32 + r32] = l_reg;
    asm volatile("s_waitcnt lgkmcnt(0)" ::: "memory");
    float rli[16];
#pragma unroll
    for (int r = 0; r < 16; ++r) rli[r] = __builtin_amdgcn_rcpf(wsf[32 + crow(r, hi)]);
    bf16_t* Ow = OA + (size_t)(tb + q0 + wid * QBLK) * 512 + h * 64;
    { LAS bf16_t* stg = (LAS bf16_t*)(shm + LDS_OST) + wid * 2048;
#pragma unroll
      for (int r = 0; r < 16; ++r) { const int orow = crow(r, hi);
#pragma unroll
          for (int d0 = 0; d0 < 2; ++d0) stg[orow * 64 + d0 * 32 + r32] = (bf16_t)(cvt_pk_bf16(o[d0][r] * rli[r], 0.f) & 0xffffu); }
      asm volatile("s_waitcnt lgkmcnt(0)" ::: "memory");
#pragma unroll
      for (int i = 0; i < 4; ++i) { const int row = i * 8 + (lane >> 3), ch = lane & 7; const u32x4 v = *(const LAS u32x4*)(stg + row * 64 + ch * 8); *(u32x4*)(Ow + (size_t)row * 512 + ch * 8) = v; } }
    asm volatile("s_waitcnt lgkmcnt(0)\n\ts_barrier" ::: "memory");
#undef MLA_DMA
}
}

#define XB_TMO      128
#define XB_XCNT(j)  (256  + 64 * (j))
#define XB_XSUB(j)  (1280 + 64 * (j))
#define XB_XGEN(j)  (2304 + 64 * (j))
#define XB_TOP      3328
#define XB_TOPGEN   3392
#define XCD_BAR_WORDS 3456
#define XB_SPIN_CAP (1u << 18)
__device__ __forceinline__ unsigned xb_ld(unsigned* p)              { return __hip_atomic_load(p, __ATOMIC_RELAXED, __HIP_MEMORY_SCOPE_AGENT); }
__device__ __forceinline__ unsigned xb_add(unsigned* p, unsigned v) { return __hip_atomic_fetch_add(p, v, __ATOMIC_RELAXED, __HIP_MEMORY_SCOPE_AGENT); }
__device__ __forceinline__ unsigned xb_xcc_id() { return (unsigned)__builtin_amdgcn_s_getreg((3 << 11) | 20) & 0xFu; }
#define XB_SPIN(cond, bar) do { unsigned _sp = 0; while (cond) { __builtin_amdgcn_s_sleep(1); \
    if ((++_sp & 255u) == 0u) { if (xb_ld(&(bar)[XB_TMO])) break; if (_sp > XB_SPIN_CAP) { atomicAdd(&(bar)[XB_TMO], 1u); break; } } } } while (0)
struct XcdBarrier { unsigned* bar; unsigned x; volatile LAS unsigned* st; };
__device__ __forceinline__ XcdBarrier xcd_barrier_post(unsigned* bar, volatile LAS unsigned* st) {
    XcdBarrier b; b.bar = bar; b.x = xb_xcc_id(); b.st = st;
    if (threadIdx.x == 0) (void)xb_add(&bar[XB_XCNT(b.x)], 1u);
    return b;
}
__device__ __forceinline__ void xcd_barrier_complete(unsigned* bar, unsigned x, unsigned& nloc, unsigned& nx) {
    const unsigned G = gridDim.x * gridDim.y * gridDim.z;
    unsigned sum, cnt, mine, sp = 0u;
    for (;;) {
        sum = 0u; cnt = 0u; mine = 0u;
#pragma unroll
        for (unsigned j = 0; j < 16; ++j) { const unsigned c = xb_ld(&bar[XB_XCNT(j)]); sum += c; cnt += (c > 0u) ? 1u : 0u; mine = (j == x) ? c : mine; }
        if (sum == G) break;
        __builtin_amdgcn_s_sleep(1);
        if ((++sp & 255u) == 0u) { if (xb_ld(&bar[XB_TMO])) break; if (sp > XB_SPIN_CAP) { atomicAdd(&bar[XB_TMO], 1u); break; } }
    }
    nloc = mine > 0u ? mine : 1u; nx = cnt > 0u ? cnt : 1u;
}
__device__ __forceinline__ void xcd_barrier(const XcdBarrier& b) {
    asm volatile("s_waitcnt vmcnt(0)" ::: "memory");
    __syncthreads();
    if (threadIdx.x == 0) {
        unsigned* bar = b.bar;
        __builtin_amdgcn_s_waitcnt(0);
        unsigned nloc = b.st[0], nx = b.st[1];
        if (nloc == 0u) { xcd_barrier_complete(bar, b.x, nloc, nx); b.st[0] = nloc; b.st[1] = nx; }
        const unsigned old = xb_add(&bar[XB_XSUB(b.x)], 1u);
        const unsigned gen = old / nloc;
        if (old + 1u == (gen + 1u) * nloc) {
            __builtin_amdgcn_fence(__ATOMIC_RELEASE, "agent");
            asm volatile("s_waitcnt vmcnt(0)" ::: "memory");
            const unsigned og = xb_add(&bar[XB_TOP], 1u);
            const unsigned tg = og / nx;
            if (og + 1u == (tg + 1u) * nx) xb_add(&bar[XB_TOPGEN], 1u);
            else XB_SPIN(xb_ld(&bar[XB_TOPGEN]) == tg, bar);
            __builtin_amdgcn_fence(__ATOMIC_ACQUIRE, "agent");
            xb_add(&bar[XB_XGEN(b.x)], 1u);
            asm volatile("s_waitcnt vmcnt(0)" ::: "memory");
        } else {
            XB_SPIN(xb_ld(&bar[XB_XGEN(b.x)]) == gen, bar);
            __builtin_amdgcn_fence(__ATOMIC_ACQUIRE, "agent");
            asm volatile("s_waitcnt vmcnt(0)" ::: "memory");
        }
    }
    __syncthreads();
}

struct Args { const float* in[19]; float* out; unsigned char* ws; int ph_lo, ph_hi; };

__device__ __forceinline__ void transpose_item(const float* W, int Nsrc, bf16_t* WT, int K, int k0, int dst_n0, int src_n0, LAS float* scr, int lane) {
#pragma unroll 8
    for (int i = 0; i < 32; ++i) { const int kk = 2 * i + (lane >> 5); scr[kk * 33 + (lane & 31)] = src_n0 >= 0 ? W[(size_t)(k0 + kk) * Nsrc + src_n0 + (lane & 31)] : 0.f; }
    asm volatile("s_waitcnt lgkmcnt(0)" ::: "memory");
    const int c = lane & 7;
#pragma unroll
    for (int j = 0; j < 4; ++j) { const int n = (lane >> 3) + 8 * j; const LAS float* s = scr + (8 * c) * 33 + n;
        u32x4 o; o.x = cvt_pk_bf16(s[0 * 33], s[1 * 33]); o.y = cvt_pk_bf16(s[2 * 33], s[3 * 33]); o.z = cvt_pk_bf16(s[4 * 33], s[5 * 33]); o.w = cvt_pk_bf16(s[6 * 33], s[7 * 33]);
        *(u32x4*)(WT + (size_t)(dst_n0 + n) * K + k0 + 8 * c) = o; }
    asm volatile("s_waitcnt lgkmcnt(0)" ::: "memory");
}
__device__ __forceinline__ void rms_row_bf16(const float* xrow, const float* gain, bf16_t* orow, int lane) {
    const f32x4* xr = (const f32x4*)xrow + lane; const f32x4* gr = (const f32x4*)gain + lane;
    f32x4 v[4]; float s = 0.f;
#pragma unroll
    for (int j = 0; j < 4; ++j) { v[j] = xr[64 * j]; s += (v[j].x * v[j].x + v[j].y * v[j].y) + (v[j].z * v[j].z + v[j].w * v[j].w); }
    const float rstd = 1.f / sqrtf(wave_sum(s) * (1.f / DM) + EPS);
    u32x2* o8 = (u32x2*)orow + lane;
#pragma unroll
    for (int j = 0; j < 4; ++j) { const f32x4 g = gr[64 * j]; u32x2 w; w.x = cvt_pk_bf16(v[j].x * rstd * g.x, v[j].y * rstd * g.y); w.y = cvt_pk_bf16(v[j].z * rstd * g.z, v[j].w * rstd * g.w); o8[64 * j] = w; }
}

__global__ void __launch_bounds__(512, 2) mega_fwd(Args args) {
    extern __shared__ __attribute__((aligned(16))) unsigned char lds_raw[];
    LAS unsigned char* lds = (LAS unsigned char*)lds_raw;
    const int tid = threadIdx.x, lane = tid & 63, wave = __builtin_amdgcn_readfirstlane(tid >> 6);
    const int G = gridDim.x, bx = blockIdx.x;
    const int vcu = (G % 8 == 0) ? (bx % 8) * (G / 8) + bx / 8 : bx;
    const int gw = vcu * 8 + wave, NGW = G * 8;
    unsigned char* ws = args.ws;
    const float* xp = args.in[0]; const float* xs = args.in[1];
    const float* norm_mix = args.in[2]; const float* w_in = args.in[3]; const float* b_gate = args.in[4]; const float* norm_q = args.in[5];
    const float* w_qb = args.in[6]; const float* norm_kv = args.in[7]; const float* w_kvb = args.in[8]; const float* rpb = args.in[9];
    const float* w_br_a = args.in[10]; const float* w_br_b = args.in[11]; const float* w_o = args.in[12]; const float* norm_ffn = args.in[13];
    const float* w_up = args.in[14]; const float* conv_w = args.in[15]; const float* conv_b = args.in[16]; const float* w_down = args.in[17]; const float* norm_final = args.in[18];
    float* out = args.out;
    f32x2* ROPE_T = (f32x2*)(ws + WS_ROPE);
    bf16_t* WIN = (bf16_t*)(ws + WS_WIN); bf16_t* WQB = (bf16_t*)(ws + WS_WQB); bf16_t* WKVB = (bf16_t*)(ws + WS_WKVB);
    bf16_t* WBRA = (bf16_t*)(ws + WS_WBRA); bf16_t* WBRB = (bf16_t*)(ws + WS_WBRB); bf16_t* WO = (bf16_t*)(ws + WS_WO);
    bf16_t* WUP = (bf16_t*)(ws + WS_WUP); bf16_t* WDN = (bf16_t*)(ws + WS_WDN);
    bf16_t* XN = (bf16_t*)(ws + WS_XN); bf16_t* KV = (bf16_t*)(ws + WS_KV); bf16_t* CQKV = (bf16_t*)(ws + WS_CQKV); bf16_t* MG = (bf16_t*)(ws + WS_MG);
    bf16_t* NAQK = (bf16_t*)(ws + WS_NAQK); bf16_t* VT = (bf16_t*)(ws + WS_VT); bf16_t* Qb = (bf16_t*)(ws + WS_Q); bf16_t* OA = (bf16_t*)(ws + WS_OA);
    bf16_t* OB = (bf16_t*)(ws + WS_OB); bf16_t* MB = (bf16_t*)(ws + WS_MB); bf16_t* KPE = (bf16_t*)(ws + WS_KPE);
    bf16_t* GB = (bf16_t*)(ws + WS_G); bf16_t* ACT = (bf16_t*)(ws + WS_ACT);
    bf16_t* GATES = (bf16_t*)out;

    const int lo = args.ph_lo, hi = args.ph_hi;
#define IN(k) (lo <= (k) && (k) < hi)
#define SEAM(k) do { if (IN(k) && IN((k) + 1)) { xcd_barrier(bar); if (PROBE_DUP == 100) xcd_barrier(bar); } } while (0)
    volatile LAS unsigned* MISC = (volatile LAS unsigned*)(lds + RING_BYTES);
    if (tid < 64) MISC[tid] = 0u;
    __syncthreads();
    XcdBarrier bar; bar.bar = (unsigned*)(ws + WS_CTL); bar.x = 0; bar.st = MISC + 8;
    if (hi - lo > 1) bar = xcd_barrier_post((unsigned*)(ws + WS_CTL), MISC + 8);
    if (lo < 0) cg::this_grid().sync();

    if (IN(0)) {
        LAS float* scr = (LAS float*)(lds + wave * 16384);
        constexpr int I_IN = (DM / 64) * (IN_PAD / 32), I_QB = (QL / 64) * (768 / 32), I_KVB = (KVL / 64) * (1024 / 32), I_BR = (512 / 64) * (1024 / 32),
                      I_O = (DM / 64) * (1024 / 32), I_UP = (DM / 64) * (5632 / 32), I_DN = (DFF / 64) * (1024 / 32);
        constexpr int NITEMS = I_IN + I_QB + I_KVB + 2 * I_BR + I_O + I_UP + I_DN;
        for (int it = gw; it < NITEMS; it += NGW) {
            int r = it;
            if (r < I_IN) { const int nb = r % (IN_PAD / 32), kb = r / (IN_PAD / 32), n0 = nb * 32; const int s0 = n0 < 1024 ? n0 : (n0 < 4608 ? n0 + 32 : (n0 < 4640 ? n0 - 3584 : -1));
                transpose_item(w_in, IN_COLS, WIN, DM, kb * 64, n0, s0, scr, lane); continue; } r -= I_IN;
            if (r < I_QB) { const int nb = r % 24, kb = r / 24, n0 = nb * 32; const int s0 = n0 < 512 ? (n0 >> 6) * 96 + (n0 & 63) : ((n0 - 512) >> 5) * 96 + 64;
                transpose_item(w_qb, 768, WQB, QL, kb * 64, n0, s0, scr, lane); continue; } r -= I_QB;
            if (r < I_KVB) { const int nb = r % 32, kb = r / 32, n0 = nb * 32; const int s0 = n0 < 512 ? (n0 >> 6) * 128 + (n0 & 63) : ((n0 - 512) >> 6) * 128 + 64 + ((n0 - 512) & 63);
                transpose_item(w_kvb, 1024, WKVB, KVL, kb * 64, n0, s0, scr, lane); continue; } r -= I_KVB;
            if (r < I_BR) { const int nb = r % 32, kb = r / 32; transpose_item(w_br_a, 1024, WBRA, 512, kb * 64, nb * 32, nb * 32, scr, lane); continue; } r -= I_BR;
            if (r < I_BR) { const int nb = r % 32, kb = r / 32; transpose_item(w_br_b, 1024, WBRB, 512, kb * 64, nb * 32, nb * 32, scr, lane); continue; } r -= I_BR;
            if (r < I_O) { const int nb = r % 32, kb = r / 32; transpose_item(w_o, 1024, WO, DM, kb * 64, nb * 32, nb * 32, scr, lane); continue; } r -= I_O;
            if (r < I_UP) { const int nb = r % 176, kb = r / 176; transpose_item(w_up, 5632, WUP, DM, kb * 64, nb * 32, nb * 32, scr, lane); continue; } r -= I_UP;
            { const int nb = r % 32, kb = r / 32; transpose_item(w_down, 1024, WDN, DFF, kb * 64, nb * 32, nb * 32, scr, lane); }
        }
        for (int m = gw; m < T; m += NGW) rms_row_bf16(m < TP ? xp + (size_t)m * DM : xs + (size_t)(m - TP) * DM, norm_mix, XN + (size_t)m * DM, lane);
        for (int i = vcu * 512 + tid; i < TS * 16; i += G * 512) { const int s = i >> 4, k = i & 15;
            double inv = 1.0; for (int q = 0; q < k; ++q) inv *= 0.5623413251903491;
            const double ang = (double)s * inv; const double nrev = __builtin_rint(ang * 0.15915494309189535);
            const float red = (float)(ang - nrev * 6.283185307179586);
            ROPE_T[i] = (f32x2){cosf(red), sinf(red)}; }
    }
    SEAM(0);
    if (IN(1)) {
        pg8::Gemm g{XN, WIN, T, IN_PAD, DM, DM, DM}; pg8::StaticOrder S; S.init(T, IN_PAD, G, bx, REPS(1));
        pg8::EpiIn E{CQKV, NAQK, VT, GATES, KPE, b_gate};
        pg8::gemm_phase(lds, g, S, E);
    }
    SEAM(1);
    if (IN(2)) {
        for (int t = gw; t < T; t += NGW) {
            bf16_t* row = CQKV + (size_t)t * 1024;
            u32x2 w[3]; float f[3][4]; float s = 0.f;
#pragma unroll
            for (int j = 0; j < 3; ++j) { w[j] = *(const u32x2*)(row + j * 256 + lane * 4); f[j][0] = bf_lo(w[j].x); f[j][1] = bf_hi(w[j].x); f[j][2] = bf_lo(w[j].y); f[j][3] = bf_hi(w[j].y);
                s += (f[j][0] * f[j][0] + f[j][1] * f[j][1]) + (f[j][2] * f[j][2] + f[j][3] * f[j][3]); }
            const u32x2 wk = *(const u32x2*)(row + 768 + lane * 4); float fk[4] = {bf_lo(wk.x), bf_hi(wk.x), bf_lo(wk.y), bf_hi(wk.y)};
            float sk = (fk[0] * fk[0] + fk[1] * fk[1]) + (fk[2] * fk[2] + fk[3] * fk[3]);
            const float rq = 1.f / sqrtf(wave_sum(s) * (1.f / QL) + EPS), rk = 1.f / sqrtf(wave_sum(sk) * (1.f / KVL) + EPS);
#pragma unroll
            for (int j = 0; j < 3; ++j) { const f32x4 gq = *(const f32x4*)(norm_q + j * 256 + lane * 4); u32x2 o; o.x = cvt_pk_bf16(f[j][0] * rq * gq.x, f[j][1] * rq * gq.y); o.y = cvt_pk_bf16(f[j][2] * rq * gq.z, f[j][3] * rq * gq.w);
                *(u32x2*)(row + j * 256 + lane * 4) = o; }
            { const f32x4 gk = *(const f32x4*)(norm_kv + lane * 4); u32x2 o; o.x = cvt_pk_bf16(fk[0] * rk * gk.x, fk[1] * rk * gk.y); o.y = cvt_pk_bf16(fk[2] * rk * gk.z, fk[3] * rk * gk.w);
                *(u32x2*)(row + 768 + lane * 4) = o; }
            if (lane < 16) { bf16_t* kp = KPE + (size_t)t * 32; const float x1 = __uint_as_float((unsigned)kp[lane] << 16), x2 = __uint_as_float((unsigned)kp[16 + lane] << 16);
                const f32x2 cs = ROPE_T[(size_t)seq_pos(t) * 16 + lane];
                const unsigned o1 = cvt_pk_bf16(x1 * cs.x - x2 * cs.y, 0.f), o2 = cvt_pk_bf16(x1 * cs.y + x2 * cs.x, 0.f);
                kp[lane] = (bf16_t)(o1 & 0xffffu); kp[16 + lane] = (bf16_t)(o2 & 0xffffu); }
        }
        LAS float* rpbl = (LAS float*)lds;
        for (int i = tid; i < 8 * 15 * 31; i += 512) rpbl[i] = rpb[i];
        __syncthreads();
        const int n16 = lane & 15, g4 = lane >> 4;
        for (int rep = 0; rep < REPS(2); ++rep)
        for (int uidx = gw; uidx < (T / 16) * 8; uidx += NGW) {
            const int h = uidx & 7, t0 = (uidx >> 3) * 16;
            const int tb = t0 < TP ? (t0 & ~4095) : TP, rows = t0 < TP ? 64 : 256;
            const int sp = t0 - tb, r = sp >> 6, c0 = sp & 63, cbk = c0 >> 4;
            const int kc0 = cbk == 0 ? 0 : (cbk == 1 ? 8 : (cbk == 2 ? 24 : 32));
            const int rs = min(max(r - 4, 0), rows - 8);
            const bf16_t* qp = NAQK + (size_t)(t0 + n16) * 1024 + h * 64 + 8 * g4;
            const bf16x8 aq0 = *(const bf16x8*)qp, aq1 = *(const bf16x8*)(qp + 32);
            f32x4 sc[16];
#pragma unroll
            for (int j = 0; j < 16; ++j) { const int kr = j >> 1, kcb = (j & 1) * 16; const int tk = tb + (rs + kr) * 64 + kc0 + kcb + n16;
                const bf16_t* kp = NAQK + (size_t)tk * 1024 + 512 + h * 64 + 8 * g4;
                const bf16x8 k0 = *(const bf16x8*)kp, k1 = *(const bf16x8*)(kp + 32);
                f32x4 a = {0.f, 0.f, 0.f, 0.f};
                a = __builtin_amdgcn_mfma_f32_16x16x32_bf16(k0, aq0, a, 0, 0, 0); a = __builtin_amdgcn_mfma_f32_16x16x32_bf16(k1, aq1, a, 0, 0, 0); sc[j] = a; }
            const int c = c0 + n16, cs = min(max(c - 8, 0), 48);
            float mx = -1e30f;
#pragma unroll
            for (int j = 0; j < 16; ++j) { const int kr = j >> 1; const int brow = (h * 15 + (rs + kr - r + 7)) * 31;
#pragma unroll
                for (int i = 0; i < 4; ++i) { const int kc = kc0 + (j & 1) * 16 + 4 * g4 + i; const bool valid = (kc >= cs) && (kc < cs + 16);
                    const int bi = valid ? (brow + kc - c + 15) : 0;
                    const float s = valid ? (sc[j][i] * 0.125f + rpbl[bi]) * LOG2E : -1e30f; sc[j][i] = s; mx = __builtin_fmaxf(mx, s); } }
            mx = __builtin_fmaxf(mx, __shfl_xor(mx, 16)); mx = __builtin_fmaxf(mx, __shfl_xor(mx, 32));
            float sum = 0.f;
#pragma unroll
            for (int j = 0; j < 16; ++j)
#pragma unroll
                for (int i = 0; i < 4; ++i) { const float p = __builtin_amdgcn_exp2f(sc[j][i] - mx); sc[j][i] = p; sum += p; }
            sum += __shfl_xor(sum, 16); sum += __shfl_xor(sum, 32);
            const float linv = 1.f / sum;
            f32x4 oacc[4];
#pragma unroll
            for (int nt = 0; nt < 4; ++nt) oacc[nt] = (f32x4){0.f, 0.f, 0.f, 0.f};
#pragma unroll
            for (int kk = 0; kk < 8; ++kk) {
                u32x4 pw; pw.x = cvt_pk_bf16(sc[2 * kk][0], sc[2 * kk][1]); pw.y = cvt_pk_bf16(sc[2 * kk][2], sc[2 * kk][3]);
                pw.z = cvt_pk_bf16(sc[2 * kk + 1][0], sc[2 * kk + 1][1]); pw.w = cvt_pk_bf16(sc[2 * kk + 1][2], sc[2 * kk + 1][3]);
                const bf16x8 pf = __builtin_bit_cast(bf16x8, pw);
                const size_t tk0 = (size_t)tb + (rs + kk) * 64 + kc0 + 4 * g4;
#pragma unroll
                for (int nt = 0; nt < 4; ++nt) { const bf16_t* vp = VT + (size_t)(h * 64 + nt * 16 + n16) * T + tk0;
                    const u32x2 v0 = *(const u32x2*)vp, v1 = *(const u32x2*)(vp + 16);
                    const u32x4 vv = {v0.x, v0.y, v1.x, v1.y};
                    oacc[nt] = __builtin_amdgcn_mfma_f32_16x16x32_bf16(__builtin_bit_cast(bf16x8, vv), pf, oacc[nt], 0, 0, 0); }
            }
            bf16_t* op = OB + (size_t)(t0 + n16) * 512 + h * 64 + 4 * g4;
#pragma unroll
            for (int nt = 0; nt < 4; ++nt) { u32x2 w; w.x = cvt_pk_bf16(oacc[nt][0] * linv, oacc[nt][1] * linv); w.y = cvt_pk_bf16(oacc[nt][2] * linv, oacc[nt][3] * linv); *(u32x2*)(op + nt * 16) = w; }
        }
        __syncthreads();
    }
    SEAM(2);
    if (IN(3)) {
        { pg8::Gemm g{CQKV, WQB, T, 768, QL, 1024, QL}; pg8::StaticOrder S; S.init(T, 768, G, bx, REPS(3)); pg8::EpiQ E{Qb, ROPE_T, C2_MLA}; pg8::gemm_phase(lds, g, S, E); }
        { pg8::Gemm g{CQKV + 768, WKVB, T, 1024, KVL, 1024, KVL}; pg8::StaticOrder S; S.init(T, 1024, G, bx, REPS(3)); pg8::EpiPlain E{KV, 1024, 1.f}; pg8::gemm_phase(lds, g, S, E); }
        { pg8::Gemm g{OB, WBRB, T, 1024, 512, 512, 512}; pg8::StaticOrder S; S.init(T, 1024, G, bx, REPS(3)); pg8::EpiGateB E{MB, GATES}; pg8::gemm_phase(lds, g, S, E); }
    }
    SEAM(3);
    if (IN(4)) for (int rep = 0; rep < REPS(4); ++rep) {
        LAS char* shm = (LAS char*)lds;
        if (G == 256) {
            for (int i = 0; i < 8; ++i) { const int bh = (vcu >> 4) + 16 * i, b = bh >> 3, h = bh & 7, qb = vcu & 15; mla::attn_unit(b * 4096, 64, h, qb * 256, Qb, KV, KPE, OA, shm); }
            for (int i = 0; i < 2; ++i) { const int h = vcu >> 5, qb = (vcu & 31) + 32 * i; mla::attn_unit(TP, 256, h, qb * 256, Qb, KV, KPE, OA, shm); }
        } else {
            for (int uix = bx; uix < 2048 + 512; uix += G) {
                if (uix < 2048) { const int bh = uix >> 4, qb = uix & 15; mla::attn_unit((bh >> 3) * 4096, 64, bh & 7, qb * 256, Qb, KV, KPE, OA, shm); }
                else { const int v = uix - 2048; mla::attn_unit(TP, 256, v >> 6, (v & 63) * 256, Qb, KV, KPE, OA, shm); }
            }
        }
    }
    SEAM(4);
    if (IN(5)) { pg8::Gemm g{OA, WBRA, T, 1024, 512, 512, 512}; pg8::StaticOrder S; S.init(T, 1024, G, bx, REPS(5)); pg8::EpiMerge E{MG, GATES, MB}; pg8::gemm_phase(lds, g, S, E); }
    SEAM(5);
    if (IN(6)) { pg8::Gemm g{MG, WO, T, 1024, DM, DM, DM}; pg8::StaticOrder S; S.init(T, 1024, G, bx, REPS(6)); pg8::EpiResid E{xp, xs, out}; pg8::gemm_phase(lds, g, S, E); }
    SEAM(6);
    if (IN(7)) for (int rep = 0; rep < REPS(7); ++rep) { for (int m = gw; m < T; m += NGW) rms_row_bf16(out + (size_t)m * DM, norm_ffn, XN + (size_t)m * DM, lane); }
    SEAM(7);
    if (IN(8)) { pg8::Gemm g{XN, WUP + (size_t)DFF * DM, T, FA, DM, DM, DM}; pg8::StaticOrder S; S.init(T, FA, G, bx, REPS(8)); pg8::EpiPlain E{GB, FA, 1.f}; pg8::gemm_phase(lds, g, S, E); }
    SEAM(8);
    if (IN(9)) { pg8::Gemm g{XN, WUP, T, FA, DM, DM, DM}; pg8::StaticOrder S; S.init(T, FA, G, bx, REPS(9)); pg8::EpiConv E{ACT, GB, FA, conv_w, conv_b, 0}; pg8::gemm_phase(lds, g, S, E); }
    SEAM(9);
    if (IN(10)) {
        { pg8::Gemm g{ACT, WDN, T, 1024, FA, FA, DFF}; pg8::StaticOrder S; S.init(T, 1024, G, bx); pg8::EpiResid E{nullptr, nullptr, out}; pg8::gemm_phase(lds, g, S, E); }
    }
    SEAM(10);
    if (IN(11)) { pg8::Gemm g{XN, WUP + (size_t)(DFF + FA) * DM, T, FB, DM, DM, DM}; pg8::StaticOrder S; S.init(T, FB, G, bx); pg8::EpiPlain E{GB, FB, 1.f}; pg8::gemm_phase(lds, g, S, E); }
    SEAM(11);
    if (IN(12)) { pg8::Gemm g{XN, WUP + (size_t)FA * DM, T, FB, DM, DM, DM}; pg8::StaticOrder S; S.init(T, FB, G, bx); pg8::EpiConv E{ACT, GB, FB, conv_w, conv_b, FA}; pg8::gemm_phase(lds, g, S, E); }
    SEAM(12);
    if (IN(13)) {
        { pg8::Gemm g{ACT, WDN + FA, T, 1024, FB, FB, DFF}; pg8::StaticOrder S; S.init(T, 1024, G, bx); pg8::EpiResid E{nullptr, nullptr, out}; pg8::gemm_phase(lds, g, S, E); }
    }
    SEAM(13);
    if (IN(14)) {
        for (int m = gw; m < T; m += NGW) {
            f32x4* xr = (f32x4*)(out + (size_t)m * DM) + lane; const f32x4* gr = (const f32x4*)norm_final + lane;
            f32x4 v[4]; float s = 0.f;
#pragma unroll
            for (int j = 0; j < 4; ++j) { v[j] = xr[64 * j]; s += (v[j].x * v[j].x + v[j].y * v[j].y) + (v[j].z * v[j].z + v[j].w * v[j].w); }
            const float rstd = 1.f / sqrtf(wave_sum(s) * (1.f / DM) + EPS);
#pragma unroll
            for (int j = 0; j < 4; ++j) { const f32x4 g = gr[64 * j]; xr[64 * j] = (f32x4){v[j].x * rstd * g.x, v[j].y * rstd * g.y, v[j].z * rstd * g.z, v[j].w * rstd * g.w}; }
        }
    }
#undef IN
#undef SEAM
}

extern "C" void kernel_launch(void* const* d_in, const int* in_sizes, int n_in, void* d_out, int out_size, void* d_ws, size_t ws_size, hipStream_t stream) {
    static int grid = 0;
    if (grid == 0) {
        if (n_in != 19 || out_size != T * DM || ws_size < WS_END) { fprintf(stderr, "kernel_launch: unexpected shapes (n_in %d, out %d, ws %zu)\n", n_in, out_size, ws_size); grid = -1; return; }
        int dev = 0, cus = 0, per_cu = 0;
        hipGetDevice(&dev); hipDeviceGetAttribute(&cus, hipDeviceAttributeMultiprocessorCount, dev);
        if (hipFuncSetAttribute((const void*)mega_fwd, hipFuncAttributeMaxDynamicSharedMemorySize, LDS_BYTES) != hipSuccess) { fprintf(stderr, "kernel_launch: hipFuncSetAttribute failed\n"); grid = -1; return; }
        if (hipOccupancyMaxActiveBlocksPerMultiprocessor(&per_cu, (const void*)mega_fwd, 512, LDS_BYTES) != hipSuccess || per_cu < 1) { fprintf(stderr, "kernel_launch: occupancy query says %d\n", per_cu); per_cu = 1; }
        (void)hipGetLastError();
        grid = cus * per_cu;
        fprintf(stderr, "kernel_launch: grid %d (cus %d x %d)\n", grid, cus, per_cu);
    }
    if (grid < 0) return;
    if (hipMemsetAsync((char*)d_ws + WS_CTL, 0, 65536, stream) != hipSuccess) { fprintf(stderr, "kernel_launch: memset failed\n"); return; }
    Args a{};
    for (int i = 0; i < 19; ++i) a.in[i] = (const float*)d_in[i];
    a.out = (float*)d_out; a.ws = (unsigned char*)d_ws;
#if MK_N_LAUNCHES == 1
    a.ph_lo = 0; a.ph_hi = NPH + 1;
    void* kargs[] = {&a};
    hipError_t e = hipLaunchCooperativeKernel((const void*)mega_fwd, dim3(grid), dim3(512), kargs, LDS_BYTES, stream);
    if (e != hipSuccess) fprintf(stderr, "cooperative launch failed: %s (grid %d)\n", hipGetErrorString(e), grid);
#else
    for (int p = 0; p <= NPH; ++p) { a.ph_lo = p; a.ph_hi = p + 1; hipLaunchKernelGGL(mega_fwd, dim3(grid), dim3(512), LDS_BYTES, stream, a); }
#endif
}
```

```cpp
#include <hip/hip_runtime.h>
#include <hip/hip_cooperative_groups.h>
#include <hip/hip_bf16.h>
#include <cstdio>
#include <cstdint>
namespace cg = cooperative_groups;

#ifndef MK_N_LAUNCHES
#define MK_N_LAUNCHES 1
#endif

#ifndef PROBE_DUP
#define PROBE_DUP -1
#endif
#define REPS(k) ((PROBE_DUP == (k)) ? 2 : 1)
#define LAS __attribute__((address_space(3)))
typedef unsigned short bf16_t;
typedef short bf16x8 __attribute__((ext_vector_type(8)));
typedef short s16x4 __attribute__((ext_vector_type(4)));
typedef float f32x4 __attribute__((ext_vector_type(4)));
typedef float f32x16 __attribute__((ext_vector_type(16)));
typedef float f32x2 __attribute__((ext_vector_type(2)));
typedef unsigned u32x4 __attribute__((ext_vector_type(4)));
typedef unsigned u32x2 __attribute__((ext_vector_type(2)));

constexpr int TP = 65536, TS = 16384, T = TP + TS;
constexpr int DM = 1024, QL = 768, KVL = 256, ROPE = 32, NAW = 512, DFF = 2816;
constexpr int IN_COLS = 4640, IN_PAD = 4864;
constexpr int NPH = 14;
constexpr float EPS = 1e-6f;
constexpr float LOG2E = 1.4426950408889634f;
constexpr float C2_MLA = 0.10206207261596577f * LOG2E;
constexpr int VTP = T + 64;
constexpr int FA = 2048, FB = 768;

constexpr size_t MiB = 1u << 20;
constexpr size_t WS_ROPE = 0;
constexpr size_t WS_WIN = 2 * MiB;
constexpr size_t WS_WQB = 12 * MiB;
constexpr size_t WS_WKVB = 14 * MiB;
constexpr size_t WS_WBRA = 15 * MiB;
constexpr size_t WS_WBRB = 16 * MiB;
constexpr size_t WS_WO = 17 * MiB;
constexpr size_t WS_WUP = 19 * MiB;
constexpr size_t WS_WDN = 30 * MiB;
constexpr size_t WS_XN = 40 * MiB;
constexpr size_t WS_KV = 40 * MiB;
constexpr size_t WS_CQKV = 200 * MiB;
constexpr size_t WS_MG = 200 * MiB;
constexpr size_t WS_NAQK = 360 * MiB;
constexpr size_t WS_VT = 860 * MiB;
constexpr size_t WS_Q = 360 * MiB;
constexpr size_t WS_OA = 480 * MiB;
constexpr size_t WS_OB = 600 * MiB;
constexpr size_t WS_MB = 680 * MiB;
constexpr size_t WS_KPE = 840 * MiB;
constexpr size_t WS_G = 200 * MiB;
constexpr size_t WS_ACT = 520 * MiB;
constexpr size_t WS_CTL = 848 * MiB;
constexpr size_t WS_END = 944 * MiB;

constexpr int RING_BYTES = 131072;
constexpr int LDS_BYTES = 147456;

__device__ __forceinline__ unsigned cvt_pk_bf16(float lo, float hi) {
    f32x2 v = {lo, hi}; typedef __bf16 bf2 __attribute__((ext_vector_type(2)));
    bf2 b = __builtin_convertvector(v, bf2); return __builtin_bit_cast(unsigned, b);
}
__device__ __forceinline__ float bf_lo(unsigned w) { return __uint_as_float(w << 16); }
__device__ __forceinline__ float bf_hi(unsigned w) { return __uint_as_float(w & 0xffff0000u); }
__device__ __forceinline__ void unpack8(u32x4 w, float (&f)[8]) {
    f[0] = bf_lo(w.x); f[1] = bf_hi(w.x); f[2] = bf_lo(w.y); f[3] = bf_hi(w.y);
    f[4] = bf_lo(w.z); f[5] = bf_hi(w.z); f[6] = bf_lo(w.w); f[7] = bf_hi(w.w);
}
__device__ __forceinline__ u32x4 pack8(const float (&f)[8]) {
    u32x4 w; w.x = cvt_pk_bf16(f[0], f[1]); w.y = cvt_pk_bf16(f[2], f[3]); w.z = cvt_pk_bf16(f[4], f[5]); w.w = cvt_pk_bf16(f[6], f[7]); return w;
}
__device__ __forceinline__ float wave_sum(float v) {
#pragma unroll
    for (int o = 1; o < 64; o <<= 1) v += __shfl_xor(v, o);
    return v;
}
__device__ __forceinline__ int seq_pos(int t) { return t < TP ? (t & 4095) : (t - TP); }
__device__ __forceinline__ float sigmoidf_(float x) { return 1.f / (1.f + __expf(-x)); }

namespace pg8 {
constexpr int BM = 256, BK = 64, HALF = 128, HTB = HALF * BK * 2, STAGE_BYTES = 8 * HTB, NXCD = 8, WGM = 8;
__host__ __device__ __forceinline__ int lds_byte(int r, int c) { const int st = (r >> 4) * 2 + (c >> 5), rr = r & 15, cc = c & 31, ob = rr * 64 + cc * 2; return st * 1024 + (ob ^ (((ob >> 9) & 1) << 5)); }
__host__ __device__ __forceinline__ void stage_rc(int b, int& R, int& C) { const int st = b / 1024, sb = b % 1024, swz = sb ^ (((sb >> 9) & 1) << 5); R = (st >> 1) * 16 + swz / 64; C = (st & 1) * 32 + (swz % 64) / 2; }
__host__ __device__ __forceinline__ int perm32(int rho) { const int n = rho >> 4, i = rho & 15; return 8 * (i >> 2) + 4 * n + (i & 3); }

struct Unit { int pm, pn; };
struct Gemm { const bf16_t* A; const bf16_t* Bt; int M, N, K, lda, ldb; };

struct StaticOrder {
    int nM, nN, nwg, G, c, reps;
    __device__ void init(int M, int N, int G_, int c_, int reps_ = 1) { nM = M / BM; nN = N / BM; nwg = nM * nN; G = G_; c = c_; reps = reps_; }
    __device__ bool next(int i, Unit& u) const {
        const long L = (long)i * G + c; if (L >= (long)nwg * reps) return false;
        int wgid = (int)(L % nwg); { const int q = nwg / NXCD, r = nwg % NXCD, xcd = wgid % NXCD, off = wgid / NXCD; wgid = (xcd < r ? xcd * (q + 1) : r * (q + 1) + (xcd - r) * q) + off; }
        const int nig = WGM * nN, gid = wgid / nig, fm = gid * WGM, gsz = (nM - fm) < WGM ? (nM - fm) : WGM;
        u.pm = fm + ((wgid % nig) % gsz); u.pn = (wgid % nig) / gsz; return true;
    }
};

template <class Epi>
__device__ __forceinline__ void gemm_phase(LAS unsigned char* lds, const Gemm g, const StaticOrder& S, const Epi& E) {
    int tid_ = threadIdx.x; asm volatile("" : "+v"(tid_));
    const int tid = tid_, wid = __builtin_amdgcn_readfirstlane(tid >> 6), lane = tid & 63, wr = wid >> 2, wc = wid & 3; int fr = lane & 15, fq = lane >> 4;
    const int K = g.K, nt = K / BK;
    unsigned voffA[2], voffB[2];
#pragma unroll
    for (int i = 0; i < 2; ++i) { int R, C; stage_rc(tid * 16 + i * 8192, R, C); const int Rb = (R & ~31) + perm32(R & 31);
        voffA[i] = (unsigned)(R * g.lda + C) * 2u; voffB[i] = (unsigned)(Rb * g.ldb + C) * 2u; }
    const size_t kstep = (size_t)(BK * 2);
    const size_t hstepA = (size_t)HALF * g.lda * 2, hstepB = (size_t)HALF * g.ldb * 2;
    const size_t tstepA = 2 * hstepA, tstepB = 2 * hstepB;
    const unsigned ldsw = (unsigned)wid * 1024u;
    const int aoff = lds_byte(wr * 64 + fr, fq * 8), boff = lds_byte(wc * 32 + fr, fq * 8);
#define PG8_SA(b, h) (((b) * 2 + (h)) * HTB)
#define PG8_SB(b, h) ((4 + (b) * 2 + (h)) * HTB)
#define PG8_STAGE(bufoff, gbase, voff) do { _Pragma("unroll") for (int _i = 0; _i < 2; ++_i) \
        __builtin_amdgcn_global_load_lds((const unsigned*)((const char*)(gbase) + (voff)[_i]), (LAS unsigned*)(lds + (bufoff) + ldsw + _i * 8192), 16, 0, 0); } while (0)
#define PG8_LDA(dst, b, h) do { _Pragma("unroll") for (int m = 0; m < 4; ++m) _Pragma("unroll") for (int k = 0; k < 2; ++k) dst[m][k] = *(const LAS bf16x8*)(lds + PG8_SA(b, h) + aoff + m * 2048 + k * 1024); } while (0)
#define PG8_LDB(dst, b, h) do { _Pragma("unroll") for (int n = 0; n < 2; ++n) _Pragma("unroll") for (int k = 0; k < 2; ++k) dst[n][k] = *(const LAS bf16x8*)(lds + PG8_SB(b, h) + boff + n * 2048 + k * 1024); } while (0)
#define PG8_MMA(ai, bj, At, Bt) do { __builtin_amdgcn_s_setprio(1); _Pragma("unroll") for (int m = 0; m < 4; ++m) _Pragma("unroll") for (int n = 0; n < 2; ++n) _Pragma("unroll") for (int k = 0; k < 2; ++k) \
        acc[ai][bj][m][n] = __builtin_amdgcn_mfma_f32_16x16x32_bf16(Bt[n][k], At[m][k], acc[ai][bj][m][n], 0, 0, 0); __builtin_amdgcn_s_setprio(0); } while (0)
#define PG8_WAIT_V(n) asm volatile("s_waitcnt vmcnt(" #n ")" ::: "memory")
#define PG8_WAIT_L(n) asm volatile("s_waitcnt lgkmcnt(" #n ")" ::: "memory")
#define PG8_BAR __builtin_amdgcn_s_barrier()
#define PG8_SCHED __builtin_amdgcn_sched_barrier(0)
    Unit cur, nxt; int ui = 0;
    if (!S.next(0, cur)) return;
    f32x4 acc[2][2][4][2];
#pragma unroll
    for (int a = 0; a < 2; ++a)
#pragma unroll
        for (int b = 0; b < 2; ++b)
#pragma unroll
            for (int m = 0; m < 4; ++m)
#pragma unroll
                for (int n = 0; n < 2; ++n) acc[a][b][m][n] = (f32x4){0.f, 0.f, 0.f, 0.f};
    bf16x8 At[4][2], B0[2][2], B1[2][2];
    const char* cA = (const char*)g.A + (size_t)cur.pm * tstepA; const char* cB = (const char*)g.Bt + (size_t)cur.pn * tstepB;
    PG8_STAGE(PG8_SB(0, 0), cB, voffB); PG8_STAGE(PG8_SB(0, 1), cB + hstepB, voffB); PG8_STAGE(PG8_SA(0, 0), cA, voffA); PG8_STAGE(PG8_SA(0, 1), cA + hstepA, voffA);
    if (wr == 1) PG8_BAR;
    PG8_WAIT_V(2); PG8_BAR;
    PG8_STAGE(PG8_SB(1, 0), cB + kstep, voffB); PG8_STAGE(PG8_SA(1, 0), cA + kstep, voffA); PG8_STAGE(PG8_SB(1, 1), cB + hstepB + kstep, voffB);
    PG8_WAIT_V(6); PG8_BAR;
    for (;;) {
        const bool has_next = S.next(ui + 1, nxt);
        const char* nA = has_next ? (const char*)g.A + (size_t)nxt.pm * tstepA : cA; const char* nB = has_next ? (const char*)g.Bt + (size_t)nxt.pn * tstepB : cB;
        for (int t = 0; t < nt; t += 2) {
            const bool last = (t == nt - 2);
            const char* a1 = cA + (size_t)(t + 1) * kstep;
            const char* a2 = last ? nA : cA + (size_t)(t + 2) * kstep; const char* b2 = last ? nB : cB + (size_t)(t + 2) * kstep;
            const char* a3 = a2 + kstep; const char* b3 = b2 + kstep;
            PG8_LDB(B0, 0, 0); PG8_LDB(B1, 0, 1); PG8_SCHED; PG8_LDA(At, 0, 0); PG8_STAGE(PG8_SA(1, 1), a1 + hstepA, voffA);
            PG8_WAIT_V(8); PG8_WAIT_L(0); PG8_BAR; PG8_MMA(0, 0, At, B0); PG8_MMA(0, 1, At, B1); PG8_BAR; PG8_SCHED;
            PG8_LDA(At, 0, 1); PG8_STAGE(PG8_SB(0, 0), b2, voffB); PG8_STAGE(PG8_SB(0, 1), b2 + hstepB, voffB); PG8_STAGE(PG8_SA(0, 0), a2, voffA);
            PG8_WAIT_V(8); PG8_WAIT_L(0); PG8_BAR; PG8_MMA(1, 0, At, B0); PG8_MMA(1, 1, At, B1); PG8_BAR; PG8_SCHED;
            PG8_LDB(B0, 1, 0); PG8_LDB(B1, 1, 1); PG8_SCHED; PG8_LDA(At, 1, 0); PG8_STAGE(PG8_SA(0, 1), a2 + hstepA, voffA);
            PG8_WAIT_V(8); PG8_WAIT_L(0); PG8_BAR; PG8_MMA(0, 0, At, B0); PG8_MMA(0, 1, At, B1); PG8_BAR; PG8_SCHED;
            PG8_LDA(At, 1, 1); PG8_STAGE(PG8_SB(1, 0), b3, voffB); PG8_STAGE(PG8_SB(1, 1), b3 + hstepB, voffB); PG8_STAGE(PG8_SA(1, 0), a3, voffA);
            PG8_WAIT_V(8); PG8_WAIT_L(0); PG8_BAR; PG8_MMA(1, 0, At, B0); PG8_MMA(1, 1, At, B1); PG8_BAR; PG8_SCHED;
        }
        if (wr == 0) PG8_BAR;
        E(acc, cur, wr, wc, fr, fq);
        if (!has_next) break;
#pragma unroll
        for (int a = 0; a < 2; ++a)
#pragma unroll
            for (int b = 0; b < 2; ++b)
#pragma unroll
                for (int m = 0; m < 4; ++m)
#pragma unroll
                    for (int n = 0; n < 2; ++n) acc[a][b][m][n] = (f32x4){0.f, 0.f, 0.f, 0.f};
        cur = nxt; cA = nA; cB = nB; ++ui;
        if (wr == 1) PG8_BAR;
    }
    PG8_WAIT_V(0);
    PG8_BAR;
#undef PG8_SA
#undef PG8_SB
#undef PG8_STAGE
#undef PG8_LDA
#undef PG8_LDB
#undef PG8_MMA
#undef PG8_WAIT_V
#undef PG8_WAIT_L
#undef PG8_BAR
#undef PG8_SCHED
}

#define EPI_LOOP_BEGIN \
    _Pragma("unroll") for (int ai = 0; ai < 2; ++ai) _Pragma("unroll") for (int m = 0; m < 4; ++m) { const int row = u.pm * BM + ai * HALF + wr * 64 + m * 16 + fr; \
    _Pragma("unroll") for (int bj = 0; bj < 2; ++bj) { const int tcol = bj * HALF + wc * 32 + 8 * fq; \
        float v[8]; { const f32x4 a0 = acc[ai][bj][m][0], a1 = acc[ai][bj][m][1]; v[0] = a0[0]; v[1] = a0[1]; v[2] = a0[2]; v[3] = a0[3]; v[4] = a1[0]; v[5] = a1[1]; v[6] = a1[2]; v[7] = a1[3]; }
#define EPI_LOOP_END } }

struct EpiPlain {
    bf16_t* O; int ldc; float scale;
    __device__ __forceinline__ void operator()(const f32x4 (&acc)[2][2][4][2], const Unit& u, int wr, int wc, int fr, int fq) const {
        EPI_LOOP_BEGIN
#pragma unroll
            for (int j = 0; j < 8; ++j) v[j] *= scale;
            *(u32x4*)(O + (size_t)row * ldc + u.pn * BM + tcol) = pack8(v);
        EPI_LOOP_END
    }
};
struct EpiIn {
    bf16_t *cqkv, *naqk, *vt, *gates, *kpe; const float* bgate;
    __device__ __forceinline__ void operator()(const f32x4 (&acc)[2][2][4][2], const Unit& u, int wr, int wc, int fr, int fq) const {
        const int pn = u.pn;
        if (pn < 8) {
            bf16_t* O = pn < 4 ? cqkv : naqk; const int cb = (pn & 3) * BM;
            EPI_LOOP_BEGIN
                *(u32x4*)(O + (size_t)row * 1024 + cb + tcol) = pack8(v);
            EPI_LOOP_END
        } else if (pn < 10) {
            const int cb = (pn - 8) * BM;
            EPI_LOOP_BEGIN
#pragma unroll
                for (int j = 0; j < 8; j += 2) { const unsigned w = cvt_pk_bf16(v[j], v[j + 1]);
                    vt[(size_t)(cb + tcol + j) * VTP + row] = (bf16_t)(w & 0xffffu); vt[(size_t)(cb + tcol + j + 1) * VTP + row] = (bf16_t)(w >> 16); }
            EPI_LOOP_END
        } else if (pn < 18) {
            const int cb = (pn - 10) * BM;
            EPI_LOOP_BEGIN
                const f32x4 b0 = *(const f32x4*)(bgate + cb + tcol), b1 = *(const f32x4*)(bgate + cb + tcol + 4);
                v[0] = sigmoidf_(v[0] + b0[0]); v[1] = sigmoidf_(v[1] + b0[1]); v[2] = sigmoidf_(v[2] + b0[2]); v[3] = sigmoidf_(v[3] + b0[3]);
                v[4] = sigmoidf_(v[4] + b1[0]); v[5] = sigmoidf_(v[5] + b1[1]); v[6] = sigmoidf_(v[6] + b1[2]); v[7] = sigmoidf_(v[7] + b1[3]);
                *(u32x4*)(gates + (size_t)row * 2048 + cb + tcol) = pack8(v);
            EPI_LOOP_END
        } else {
            if (wc == 0) {
                EPI_LOOP_BEGIN
                    if (bj == 0) *(u32x4*)(kpe + (size_t)row * 32 + tcol) = pack8(v);
                EPI_LOOP_END
            }
        }
    }
};
struct EpiQ {
    bf16_t* Q; const f32x2* rope; float scale;
    __device__ __forceinline__ void operator()(const f32x4 (&acc)[2][2][4][2], const Unit& u, int wr, int wc, int fr, int fq) const {
        if (u.pn < 2) {
            EPI_LOOP_BEGIN
#pragma unroll
                for (int j = 0; j < 8; ++j) v[j] *= scale;
                *(u32x4*)(Q + (size_t)row * 768 + u.pn * BM + tcol) = pack8(v);
            EPI_LOOP_END
        } else {
            EPI_LOOP_BEGIN
                const f32x2* rp = rope + (size_t)seq_pos(row) * 16 + (fq & 1) * 8;
#pragma unroll
                for (int j = 0; j < 8; ++j) { const float other = __shfl_xor(v[j], 32); const f32x2 cs = rp[j];
                    const float x1 = (fq < 2) ? v[j] : other, x2 = (fq < 2) ? other : v[j];
                    v[j] = ((fq < 2) ? (x1 * cs.x - x2 * cs.y) : (x1 * cs.y + x2 * cs.x)) * scale; }
                *(u32x4*)(Q + (size_t)row * 768 + 512 + tcol) = pack8(v);
            EPI_LOOP_END
        }
    }
};
struct EpiKV {
    bf16_t* Kh; bf16_t* Vh;
    __device__ __forceinline__ void operator()(const f32x4 (&acc)[2][2][4][2], const Unit& u, int wr, int wc, int fr, int fq) const {
        { int t_ = threadIdx.x; asm volatile("" : "+v"(t_)); fr = t_ & 15; fq = (t_ >> 4) & 3; }
        const int row0 = u.pm * BM;
        const int tb = row0 < TP ? (row0 & ~4095) : TP, S = row0 < TP ? 4096 : 16384;
        bf16_t* base = (u.pn < 2 ? Kh : Vh) + (size_t)tb * 512;
        const int lane_off = (wr * 64 + fr + row0 - tb) * 64 + (wc & 1) * 32 + 8 * fq;
#pragma unroll
        for (int bj = 0; bj < 2; ++bj) {
            const int h = (u.pn & 1) * 4 + bj * 2 + (wc >> 1);
            bf16_t* hb = base + (size_t)h * S * 64;
#pragma unroll
            for (int ai = 0; ai < 2; ++ai)
#pragma unroll
                for (int m = 0; m < 4; ++m) {
                    const f32x4 a0 = acc[ai][bj][m][0], a1 = acc[ai][bj][m][1];
                    u32x4 w; w.x = cvt_pk_bf16(a0[0], a0[1]); w.y = cvt_pk_bf16(a0[2], a0[3]); w.z = cvt_pk_bf16(a1[0], a1[1]); w.w = cvt_pk_bf16(a1[2], a1[3]);
                    *(u32x4*)(hb + lane_off + (ai * HALF + m * 16) * 64) = w;
                }
        }
    }
};
struct EpiGateB {
    bf16_t* O; const bf16_t* gates;
    __device__ __forceinline__ void operator()(const f32x4 (&acc)[2][2][4][2], const Unit& u, int wr, int wc, int fr, int fq) const {
        EPI_LOOP_BEGIN
            const int col = u.pn * BM + tcol; float g[8]; unpack8(*(const u32x4*)(gates + (size_t)row * 2048 + 1024 + col), g);
#pragma unroll
            for (int j = 0; j < 8; ++j) v[j] *= g[j];
            *(u32x4*)(O + (size_t)row * 1024 + col) = pack8(v);
        EPI_LOOP_END
    }
};
struct EpiMerge {
    bf16_t* O; const bf16_t* gates; const bf16_t* mb;
    __device__ __forceinline__ void operator()(const f32x4 (&acc)[2][2][4][2], const Unit& u, int wr, int wc, int fr, int fq) const {
        EPI_LOOP_BEGIN
            const int col = u.pn * BM + tcol; float g[8], b[8];
            unpack8(*(const u32x4*)(gates + (size_t)row * 2048 + col), g); unpack8(*(const u32x4*)(mb + (size_t)row * 1024 + col), b);
#pragma unroll
            for (int j = 0; j < 8; ++j) v[j] = v[j] * g[j] + b[j];
            *(u32x4*)(O + (size_t)row * 1024 + col) = pack8(v);
        EPI_LOOP_END
    }
};
struct EpiResid {
    const float* xp; const float* xs; float* out;
    __device__ __forceinline__ void operator()(const f32x4 (&acc)[2][2][4][2], const Unit& u, int wr, int wc, int fr, int fq) const {
        EPI_LOOP_BEGIN
            const int col = u.pn * BM + tcol;
            const float* bp = xp ? (row < TP ? xp + (size_t)row * DM : xs + (size_t)(row - TP) * DM) : out + (size_t)row * DM;
            const f32x4 b0 = *(const f32x4*)(bp + col), b1 = *(const f32x4*)(bp + col + 4);
            f32x4 o0 = {v[0] + b0[0], v[1] + b0[1], v[2] + b0[2], v[3] + b0[3]}, o1 = {v[4] + b1[0], v[5] + b1[1], v[6] + b1[2], v[7] + b1[3]};
            *(f32x4*)(out + (size_t)row * DM + col) = o0; *(f32x4*)(out + (size_t)row * DM + col + 4) = o1;
        EPI_LOOP_END
    }
};
struct EpiConv {
    bf16_t* O; const bf16_t* G; int ldg; const float* cw; const float* cb; int ch_off;
    __device__ __forceinline__ void operator()(const f32x4 (&acc)[2][2][4][2], const Unit& u, int wr, int wc, int fr, int fq) const {
#pragma unroll
        for (int bj = 0; bj < 2; ++bj) {
            const int lc = u.pn * BM + bj * HALF + wc * 32 + 8 * fq, ch = ch_off + lc;
            float w0[8], w1[8], w2[8], bb[8];
#pragma unroll
            for (int j = 0; j < 8; j += 4) { const f32x4 a = *(const f32x4*)(cw + ch + j), b = *(const f32x4*)(cw + DFF + ch + j), c = *(const f32x4*)(cw + 2 * DFF + ch + j), d = *(const f32x4*)(cb + ch + j);
#pragma unroll
                for (int i = 0; i < 4; ++i) { w0[j + i] = a[i]; w1[j + i] = b[i]; w2[j + i] = c[i]; bb[j + i] = d[i]; } }
#pragma unroll
            for (int ai = 0; ai < 2; ++ai)
#pragma unroll
                for (int m = 0; m < 4; ++m) {
                    const int row = u.pm * BM + ai * HALF + wr * 64 + m * 16 + fr;
                    const bool hasl = row < TP ? ((row & 4095) != 0) : (row != TP);
                    const bool hasr = row < TP ? ((row & 4095) != 4095) : (row != T - 1);
                    const bf16_t* gp = G + (size_t)row * ldg + lc;
                    float gm[8], gc[8], gn[8];
                    unpack8(*(const u32x4*)gp, gc);
                    if (hasl) unpack8(*(const u32x4*)(gp - ldg), gm); else { _Pragma("unroll") for (int j = 0; j < 8; ++j) gm[j] = 0.f; }
                    if (hasr) unpack8(*(const u32x4*)(gp + ldg), gn); else { _Pragma("unroll") for (int j = 0; j < 8; ++j) gn[j] = 0.f; }
                    const f32x4 a0 = acc[ai][bj][m][0], a1 = acc[ai][bj][m][1];
                    float uu[8] = {a0[0], a0[1], a0[2], a0[3], a1[0], a1[1], a1[2], a1[3]}; float o[8];
#pragma unroll
                    for (int j = 0; j < 8; ++j) { const float gg = gm[j] * w0[j] + gc[j] * w1[j] + gn[j] * w2[j] + bb[j]; o[j] = gg * sigmoidf_(gg) * uu[j]; }
                    *(u32x4*)(O + (size_t)row * ldg + lc) = pack8(o);
                }
        }
    }
};
}

namespace mla {
constexpr int NW = 8, QBLK = 32, QB = 256, KVBLK = 64;
constexpr int NSLOT = 3, KSLOT = 12288, VSLOT = 8192;
constexpr int LDS_K = 0, LDS_V = NSLOT * KSLOT, LDS_WS = LDS_V + NSLOT * VSLOT, LDS_OST = LDS_WS + NW * 64 * 4, LDS_TOTAL = LDS_OST + NW * 4096;
static_assert(LDS_TOTAL <= RING_BYTES, "mla lds");
typedef LAS const char* lds_cptr;
__device__ __forceinline__ int crow(int r, int hi) { return (r & 3) + 8 * (r >> 2) + 4 * hi; }
__device__ __forceinline__ void glds16(const void* gsrc, unsigned lds_dst) { unsigned keep;
    asm volatile("s_mov_b32 %0, m0\n\ts_mov_b32 m0, %2\n\ts_nop 0\n\tglobal_load_lds_dwordx4 %1, off\n\ts_mov_b32 m0, %0" : "=&s"(keep) : "v"(gsrc), "s"(lds_dst) : "memory"); }
#define MLA_WAIT_BAR(N) asm volatile("s_waitcnt vmcnt(" #N ") lgkmcnt(0)\n\ts_barrier" ::: "memory")

__device__ __forceinline__ float max3f(float a, float b, float c) { float r; asm("v_max3_f32 %0, %1, %2, %3" : "=v"(r) : "v"(a), "v"(b), "v"(c)); return r; }
__device__ __forceinline__ float max2f(float a, float b) { float r; asm("v_max_f32_e32 %0, %1, %2" : "=v"(r) : "v"(a), "v"(b)); return r; }
__device__ __forceinline__ float max16f(const f32x16& p) {
    float r;
    asm("v_max3_f32 %0, %1, %2, %3\n\tv_max3_f32 %0, %0, %4, %5\n\tv_max3_f32 %0, %0, %6, %7\n\tv_max3_f32 %0, %0, %8, %9\n\t"
        "v_max3_f32 %0, %0, %10, %11\n\tv_max3_f32 %0, %0, %12, %13\n\tv_max3_f32 %0, %0, %14, %15\n\tv_max_f32_e32 %0, %0, %16"
        : "=&v"(r) : "v"(p[0]), "v"(p[1]), "v"(p[2]), "v"(p[3]), "v"(p[4]), "v"(p[5]), "v"(p[6]), "v"(p[7]), "v"(p[8]), "v"(p[9]), "v"(p[10]), "v"(p[11]), "v"(p[12]), "v"(p[13]), "v"(p[14]), "v"(p[15]));
    return r;
}
__device__ __forceinline__ float rowmax32(const f32x16& p0, const f32x16& p1) {
    const float m = max2f(max16f(p0), max16f(p1));
    auto rr = __builtin_amdgcn_permlane32_swap(__float_as_uint(m), __float_as_uint(m), false, false);
    return max2f(__uint_as_float(rr[0]), __uint_as_float(rr[1]));
}
__device__ __forceinline__ void pv(f32x16* o, int vb, bf16x8 pa0, bf16x8 pa1, bf16x8 pa2, bf16x8 pa3) {
#pragma unroll
    for (int d0 = 0; d0 < 2; ++d0) { s16x4 lo[4], hi[4];
#pragma unroll
        for (int ks = 0; ks < 4; ++ks) {
            asm volatile("ds_read_b64_tr_b16 %0,%1 offset:%c2" : "=&v"(lo[ks]) : "v"(vb), "i"(d0 * 4096 + ks * 1024) : "memory");
            asm volatile("ds_read_b64_tr_b16 %0,%1 offset:%c2" : "=&v"(hi[ks]) : "v"(vb), "i"(d0 * 4096 + ks * 1024 + 512) : "memory"); }
        asm volatile("s_waitcnt lgkmcnt(0)" ::: "memory"); __builtin_amdgcn_sched_barrier(0);
#define MLA_PK(k) (bf16x8){lo[k][0], lo[k][1], lo[k][2], lo[k][3], hi[k][0], hi[k][1], hi[k][2], hi[k][3]}
        o[d0] = __builtin_amdgcn_mfma_f32_32x32x16_bf16(pa0, MLA_PK(0), o[d0], 0, 0, 0);
        o[d0] = __builtin_amdgcn_mfma_f32_32x32x16_bf16(pa1, MLA_PK(1), o[d0], 0, 0, 0);
        o[d0] = __builtin_amdgcn_mfma_f32_32x32x16_bf16(pa2, MLA_PK(2), o[d0], 0, 0, 0);
        o[d0] = __builtin_amdgcn_mfma_f32_32x32x16_bf16(pa3, MLA_PK(3), o[d0], 0, 0, 0);
#undef MLA_PK
    }
}

__device__ __forceinline__ s16x4 vtr(lds_cptr p) { typedef short v4i16_t __attribute__((ext_vector_type(4))); return __builtin_bit_cast(s16x4, __builtin_amdgcn_ds_read_tr16_b64_v4i16((LAS v4i16_t*)p)); }
template <int VAR> __device__ __forceinline__ void attn_unit(int tb, int NT, int h, int q0, const bf16_t* Q, const bf16_t* __restrict__ KV, const bf16_t* __restrict__ KPE, bf16_t* OA, LAS char* shm) {
    const int tid = threadIdx.x, lane = tid & 63, r32 = lane & 31, hi = lane >> 5; const int wid = __builtin_amdgcn_readfirstlane(tid >> 6);
    const int grp = wid >> 2;
    const unsigned lds0 = (unsigned)(uintptr_t)shm;
    LAS float* wsf = (LAS float*)(shm + LDS_WS) + wid * 64;
    asm volatile("s_waitcnt vmcnt(0)" ::: "memory");
    const bf16_t* Qw = Q + (size_t)(tb + q0 + wid * QBLK + r32) * 768;
    bf16x8 qr[6];
#pragma unroll
    for (int d0 = 0; d0 < 4; ++d0) qr[d0] = *(const bf16x8*)(Qw + h * 64 + d0 * 16 + hi * 8);
#pragma unroll
    for (int d0 = 0; d0 < 2; ++d0) qr[4 + d0] = *(const bf16x8*)(Qw + 512 + h * 32 + d0 * 16 + hi * 8);
    const size_t hb = ((size_t)tb * 8 + (size_t)h * NT * KVBLK) * 64;
    const bf16_t* ksrc = KV + hb + (size_t)lane * 64 + wid * 8;
    const bf16_t* rsrc = KPE + (size_t)(tb + lane) * 32 + (wid & 3) * 8;
    const bf16_t* vsrc = KV + (size_t)T * 512 + hb + (size_t)(16 * (wid & 3) + (lane >> 2)) * 64 + (wid >> 2) * 32 + (lane & 3) * 8;
    const unsigned kdst = lds0 + LDS_K + wid * 1024, rdst = lds0 + LDS_K + (8 + (wid & 3)) * 1024, vdst = lds0 + LDS_V + wid * 1024;
#define MLA_DMA_K(t, s) do { glds16(ksrc + (size_t)(t) * KVBLK * 64, (unsigned)__builtin_amdgcn_readfirstlane(kdst + (s) * KSLOT)); \
        glds16(rsrc + (size_t)(t) * KVBLK * 32, (unsigned)__builtin_amdgcn_readfirstlane(rdst + (s) * KSLOT)); } while (0)
#define MLA_DMA_V(t, s) glds16(vsrc + (size_t)(t) * KVBLK * 64, (unsigned)__builtin_amdgcn_readfirstlane(vdst + (s) * VSLOT))
#define MLA_SB() __builtin_amdgcn_sched_barrier(0)
    const lds_cptr kp0 = (lds_cptr)shm + LDS_K + hi * 1024 + r32 * 16;
    const lds_cptr vp0 = (lds_cptr)shm + LDS_V + ((lane >> 4) & 1) * 32 + (lane & 3) * 8 + (4 * hi + ((lane & 15) >> 2)) * 64;
    MLA_DMA_K(0, 0); MLA_DMA_K(1, 1); MLA_DMA_V(0, 0);
    float mhat = 0.f; f32x16 o[2]; o[0] = f32x16{}; o[1] = f32x16{}; f32x16 negm = f32x16{};
    f32x16 osum = f32x16{};
    const bf16x8 ones = {16256, 16256, 16256, 16256, 16256, 16256, 16256, 16256};
    f32x16 p0, p1; u32x4 pw0 = {0u, 0u, 0u, 0u}, pw1 = pw0, pw2 = pw0, pw3 = pw0;
    MLA_WAIT_BAR(3);
    if (grp) { asm volatile("s_barrier" ::: "memory"); }
    int slot = 0;
#define MLA_VLOAD(vs) do { const lds_cptr vp_ = vp0 + (vs) * VSLOT; \
        _Pragma("unroll") for (int i_ = 0; i_ < 8; ++i_) { vlo[i_] = vtr(vp_ + (i_ >> 2) * 4096 + (i_ & 3) * 1024); vhi[i_] = vtr(vp_ + (i_ >> 2) * 4096 + (i_ & 3) * 1024 + 512); } } while (0)
#define MLA_VF(i) ((bf16x8){vlo[i][0], vlo[i][1], vlo[i][2], vlo[i][3], vhi[i][0], vhi[i][1], vhi[i][2], vhi[i][3]})
#define MLA_PVM() do { \
        o[0] = __builtin_amdgcn_mfma_f32_32x32x16_bf16(__builtin_bit_cast(bf16x8, pw0), MLA_VF(0), o[0], 0, 0, 0); o[1] = __builtin_amdgcn_mfma_f32_32x32x16_bf16(__builtin_bit_cast(bf16x8, pw0), MLA_VF(4), o[1], 0, 0, 0); \
        o[0] = __builtin_amdgcn_mfma_f32_32x32x16_bf16(__builtin_bit_cast(bf16x8, pw1), MLA_VF(1), o[0], 0, 0, 0); o[1] = __builtin_amdgcn_mfma_f32_32x32x16_bf16(__builtin_bit_cast(bf16x8, pw1), MLA_VF(5), o[1], 0, 0, 0); \
        o[0] = __builtin_amdgcn_mfma_f32_32x32x16_bf16(__builtin_bit_cast(bf16x8, pw2), MLA_VF(2), o[0], 0, 0, 0); o[1] = __builtin_amdgcn_mfma_f32_32x32x16_bf16(__builtin_bit_cast(bf16x8, pw2), MLA_VF(6), o[1], 0, 0, 0); \
        o[0] = __builtin_amdgcn_mfma_f32_32x32x16_bf16(__builtin_bit_cast(bf16x8, pw3), MLA_VF(3), o[0], 0, 0, 0); o[1] = __builtin_amdgcn_mfma_f32_32x32x16_bf16(__builtin_bit_cast(bf16x8, pw3), MLA_VF(7), o[1], 0, 0, 0); \
        osum = __builtin_amdgcn_mfma_f32_32x32x16_bf16(__builtin_bit_cast(bf16x8, pw0), ones, osum, 0, 0, 0); osum = __builtin_amdgcn_mfma_f32_32x32x16_bf16(__builtin_bit_cast(bf16x8, pw1), ones, osum, 0, 0, 0); \
        osum = __builtin_amdgcn_mfma_f32_32x32x16_bf16(__builtin_bit_cast(bf16x8, pw2), ones, osum, 0, 0, 0); osum = __builtin_amdgcn_mfma_f32_32x32x16_bf16(__builtin_bit_cast(bf16x8, pw3), ones, osum, 0, 0, 0); } while (0)
    s16x4 vlo[8], vhi[8]; bf16x8 kf[12];
    for (int t = 0; t < NT; ++t) {
        const int sprev = (slot == 0) ? 2 : slot - 1, snext = (slot == 2) ? 0 : slot + 1;
        if (VAR != 1) { if (t + 2 < NT) MLA_DMA_K(t + 2, sprev);
        if (t + 1 < NT) MLA_DMA_V(t + 1, snext); }
        if (t > 0) MLA_VLOAD(sprev);
        { const lds_cptr kb = kp0 + slot * KSLOT;
#pragma unroll
          for (int d0 = 0; d0 < 6; ++d0) { kf[2 * d0] = *(const LAS bf16x8*)(kb + d0 * 2048); kf[2 * d0 + 1] = *(const LAS bf16x8*)(kb + d0 * 2048 + 512); } }
        MLA_SB();
        if (t > 0) MLA_PVM();
        p0 = __builtin_amdgcn_mfma_f32_32x32x16_bf16(kf[0], qr[0], negm, 0, 0, 0); p1 = __builtin_amdgcn_mfma_f32_32x32x16_bf16(kf[1], qr[0], negm, 0, 0, 0);
#pragma unroll
        for (int d0 = 1; d0 < 6; ++d0) { p0 = __builtin_amdgcn_mfma_f32_32x32x16_bf16(kf[2 * d0], qr[d0], p0, 0, 0, 0); p1 = __builtin_amdgcn_mfma_f32_32x32x16_bf16(kf[2 * d0 + 1], qr[d0], p1, 0, 0, 0); }
        MLA_SB();
        if (VAR != 1 && t + 2 < NT) { MLA_WAIT_BAR(3); } else { MLA_WAIT_BAR(0); }
        MLA_SB();
        asm volatile("s_nop 15\n\ts_nop 7" : "+v"(p0), "+v"(p1));
        if (VAR == 2) { pw0 = (u32x4){__float_as_uint(p0[0]), __float_as_uint(p0[1]), __float_as_uint(p1[0]), __float_as_uint(p1[1])}; pw1 = pw0; pw2 = pw0; pw3 = pw0; } else {
        const float rm = rowmax32(p0, p1);
        if (t == 0) {
            mhat = rm;
#pragma unroll
            for (int r = 0; r < 16; ++r) { p0[r] -= rm; p1[r] -= rm; negm[r] = -mhat; }
        } else if (__any(rm > 8.0f)) {
            const float dl = __builtin_fmaxf(rm, 0.f); mhat += dl;
#pragma unroll
            for (int r = 0; r < 16; ++r) { p0[r] -= dl; p1[r] -= dl; negm[r] = -mhat; }
            const float f = __builtin_amdgcn_exp2f(-dl);
            if (hi == 0) wsf[r32] = f;
            asm volatile("s_waitcnt lgkmcnt(0)" ::: "memory");
#pragma unroll
            for (int r = 0; r < 16; ++r) { const float fr_ = wsf[crow(r, hi)]; o[0][r] *= fr_; o[1][r] *= fr_; osum[r] *= fr_; }
        }
#pragma unroll
        for (int r = 0; r < 16; ++r) { p0[r] = __builtin_amdgcn_exp2f(p0[r]); p1[r] = __builtin_amdgcn_exp2f(p1[r]); }
        pw0 = (u32x4){cvt_pk_bf16(p0[0], p0[1]), cvt_pk_bf16(p0[2], p0[3]), cvt_pk_bf16(p0[4], p0[5]), cvt_pk_bf16(p0[6], p0[7])};
        pw1 = (u32x4){cvt_pk_bf16(p0[8], p0[9]), cvt_pk_bf16(p0[10], p0[11]), cvt_pk_bf16(p0[12], p0[13]), cvt_pk_bf16(p0[14], p0[15])};
        pw2 = (u32x4){cvt_pk_bf16(p1[0], p1[1]), cvt_pk_bf16(p1[2], p1[3]), cvt_pk_bf16(p1[4], p1[5]), cvt_pk_bf16(p1[6], p1[7])};
        pw3 = (u32x4){cvt_pk_bf16(p1[8], p1[9]), cvt_pk_bf16(p1[10], p1[11]), cvt_pk_bf16(p1[12], p1[13]), cvt_pk_bf16(p1[14], p1[15])};
        }
        asm volatile("" : "+v"(pw0), "+v"(pw1), "+v"(pw2), "+v"(pw3));
        MLA_SB();
        asm volatile("s_waitcnt lgkmcnt(0)\n\ts_barrier" ::: "memory");
        MLA_SB();
        slot = snext;
    }
    { const int sprev = (slot == 0) ? 2 : slot - 1; MLA_VLOAD(sprev); MLA_SB(); MLA_PVM(); }
    MLA_SB();
    if (!grp) { asm volatile("s_waitcnt lgkmcnt(0)\n\ts_barrier" ::: "memory"); }
    float rli[16];
#pragma unroll
    for (int r = 0; r < 16; ++r) rli[r] = __builtin_amdgcn_rcpf(osum[r]);
    bf16_t* Ow = OA + (size_t)(tb + q0 + wid * QBLK) * 512 + h * 64;
    { LAS bf16_t* stg = (LAS bf16_t*)(shm + LDS_OST) + wid * 2048;
#pragma unroll
      for (int r = 0; r < 16; ++r) { const int orow = crow(r, hi);
#pragma unroll
          for (int d0 = 0; d0 < 2; ++d0) stg[orow * 64 + d0 * 32 + r32] = (bf16_t)(cvt_pk_bf16(o[d0][r] * rli[r], 0.f) & 0xffffu); }
      asm volatile("s_waitcnt lgkmcnt(0)" ::: "memory");
#pragma unroll
      for (int i = 0; i < 4; ++i) { const int row = i * 8 + (lane >> 3), ch = lane & 7; const u32x4 v = *(const LAS u32x4*)(stg + row * 64 + ch * 8); *(u32x4*)(Ow + (size_t)row * 512 + ch * 8) = v; } }
    asm volatile("s_waitcnt lgkmcnt(0)\n\ts_barrier" ::: "memory");
#undef MLA_DMA_K
#undef MLA_DMA_V
#undef MLA_VLOAD
#undef MLA_VF
#undef MLA_PVM
#undef MLA_SB
}
}

#define XB_TMO      128
#define XB_XCNT(j)  (256  + 64 * (j))
#define XB_XSUB(j)  (1280 + 64 * (j))
#define XB_XGEN(j)  (2304 + 64 * (j))
#define XB_TOP      3328
#define XB_TOPGEN   3392
#define XCD_BAR_WORDS 3456
#define XB_SPIN_CAP (1u << 18)
__device__ __forceinline__ unsigned xb_ld(unsigned* p)              { return __hip_atomic_load(p, __ATOMIC_RELAXED, __HIP_MEMORY_SCOPE_AGENT); }
__device__ __forceinline__ unsigned xb_add(unsigned* p, unsigned v) { return __hip_atomic_fetch_add(p, v, __ATOMIC_RELAXED, __HIP_MEMORY_SCOPE_AGENT); }
__device__ __forceinline__ unsigned xb_xcc_id() { return (unsigned)__builtin_amdgcn_s_getreg((3 << 11) | 20) & 0xFu; }
#define XB_SPIN(cond, bar) do { unsigned _sp = 0; while (cond) { __builtin_amdgcn_s_sleep(1); \
    if ((++_sp & 255u) == 0u) { if (xb_ld(&(bar)[XB_TMO])) break; if (_sp > XB_SPIN_CAP) { atomicAdd(&(bar)[XB_TMO], 1u); break; } } } } while (0)
struct XcdBarrier { unsigned* bar; unsigned x; volatile LAS unsigned* st; };
__device__ __forceinline__ XcdBarrier xcd_barrier_post(unsigned* bar, volatile LAS unsigned* st) {
    XcdBarrier b; b.bar = bar; b.x = xb_xcc_id(); b.st = st;
    if (threadIdx.x == 0) (void)xb_add(&bar[XB_XCNT(b.x)], 1u);
    return b;
}
__device__ __forceinline__ void xcd_barrier_complete(unsigned* bar, unsigned x, unsigned& nloc, unsigned& nx) {
    const unsigned G = gridDim.x * gridDim.y * gridDim.z;
    unsigned sum, cnt, mine, sp = 0u;
    for (;;) {
        sum = 0u; cnt = 0u; mine = 0u;
#pragma unroll
        for (unsigned j = 0; j < 16; ++j) { const unsigned c = xb_ld(&bar[XB_XCNT(j)]); sum += c; cnt += (c > 0u) ? 1u : 0u; mine = (j == x) ? c : mine; }
        if (sum == G) break;
        __builtin_amdgcn_s_sleep(1);
        if ((++sp & 255u) == 0u) { if (xb_ld(&bar[XB_TMO])) break; if (sp > XB_SPIN_CAP) { atomicAdd(&bar[XB_TMO], 1u); break; } }
    }
    nloc = mine > 0u ? mine : 1u; nx = cnt > 0u ? cnt : 1u;
}
__device__ __forceinline__ void xcd_barrier(const XcdBarrier& b) {
    asm volatile("s_waitcnt vmcnt(0)" ::: "memory");
    __syncthreads();
    if (threadIdx.x == 0) {
        unsigned* bar = b.bar;
        __builtin_amdgcn_s_waitcnt(0);
        unsigned nloc = b.st[0], nx = b.st[1];
        if (nloc == 0u) { xcd_barrier_complete(bar, b.x, nloc, nx); b.st[0] = nloc; b.st[1] = nx; }
        const unsigned old = xb_add(&bar[XB_XSUB(b.x)], 1u);
        const unsigned gen = old / nloc;
        if (old + 1u == (gen + 1u) * nloc) {
            __builtin_amdgcn_fence(__ATOMIC_RELEASE, "agent");
            asm volatile("s_waitcnt vmcnt(0)" ::: "memory");
            const unsigned og = xb_add(&bar[XB_TOP], 1u);
            const unsigned tg = og / nx;
            if (og + 1u == (tg + 1u) * nx) xb_add(&bar[XB_TOPGEN], 1u);
            else XB_SPIN(xb_ld(&bar[XB_TOPGEN]) == tg, bar);
            __builtin_amdgcn_fence(__ATOMIC_ACQUIRE, "agent");
            xb_add(&bar[XB_XGEN(b.x)], 1u);
            asm volatile("s_waitcnt vmcnt(0)" ::: "memory");
        } else {
            XB_SPIN(xb_ld(&bar[XB_XGEN(b.x)]) == gen, bar);
            __builtin_amdgcn_fence(__ATOMIC_ACQUIRE, "agent");
            asm volatile("s_waitcnt vmcnt(0)" ::: "memory");
        }
    }
    __syncthreads();
}

struct Args { const float* in[19]; float* out; unsigned char* ws; int ph_lo, ph_hi; };

__device__ __forceinline__ void transpose_item(const float* W, int Nsrc, bf16_t* WT, int K, int k0, int dst_n0, int src_n0, LAS float* scr, int lane) {
#pragma unroll 8
    for (int i = 0; i < 32; ++i) { const int kk = 2 * i + (lane >> 5); scr[kk * 33 + (lane & 31)] = src_n0 >= 0 ? W[(size_t)(k0 + kk) * Nsrc + src_n0 + (lane & 31)] : 0.f; }
    asm volatile("s_waitcnt lgkmcnt(0)" ::: "memory");
    const int c = lane & 7;
#pragma unroll
    for (int j = 0; j < 4; ++j) { const int n = (lane >> 3) + 8 * j; const LAS float* s = scr + (8 * c) * 33 + n;
        u32x4 o; o.x = cvt_pk_bf16(s[0 * 33], s[1 * 33]); o.y = cvt_pk_bf16(s[2 * 33], s[3 * 33]); o.z = cvt_pk_bf16(s[4 * 33], s[5 * 33]); o.w = cvt_pk_bf16(s[6 * 33], s[7 * 33]);
        *(u32x4*)(WT + (size_t)(dst_n0 + n) * K + k0 + 8 * c) = o; }
    asm volatile("s_waitcnt lgkmcnt(0)" ::: "memory");
}
__device__ __forceinline__ void rms_row_bf16(const float* xrow, const float* gain, bf16_t* orow, int lane) {
    const f32x4* xr = (const f32x4*)xrow + lane; const f32x4* gr = (const f32x4*)gain + lane;
    f32x4 v[4]; float s = 0.f;
#pragma unroll
    for (int j = 0; j < 4; ++j) { v[j] = xr[64 * j]; s += (v[j].x * v[j].x + v[j].y * v[j].y) + (v[j].z * v[j].z + v[j].w * v[j].w); }
    const float rstd = 1.f / sqrtf(wave_sum(s) * (1.f / DM) + EPS);
    u32x2* o8 = (u32x2*)orow + lane;
#pragma unroll
    for (int j = 0; j < 4; ++j) { const f32x4 g = gr[64 * j]; u32x2 w; w.x = cvt_pk_bf16(v[j].x * rstd * g.x, v[j].y * rstd * g.y); w.y = cvt_pk_bf16(v[j].z * rstd * g.z, v[j].w * rstd * g.w); o8[64 * j] = w; }
}

__global__ void __launch_bounds__(512, 2) mega_fwd(Args args) {
    extern __shared__ __attribute__((aligned(16))) unsigned char lds_raw[];
    LAS unsigned char* lds = (LAS unsigned char*)lds_raw;
    const int wave = __builtin_amdgcn_readfirstlane((int)threadIdx.x >> 6);
#define OPAQUE_TID() int tid = threadIdx.x; asm volatile("" : "+v"(tid)); const int lane = tid & 63; (void)lane
    const int G = gridDim.x, bx = blockIdx.x;
    const int vcu = (G % 8 == 0) ? (bx % 8) * (G / 8) + bx / 8 : bx;
    const int gw = vcu * 8 + wave, NGW = G * 8;
#define ws (args.ws)
#define xp (args.in[0])
#define xs (args.in[1])
#define norm_mix (args.in[2])
#define w_in (args.in[3])
#define b_gate (args.in[4])
#define norm_q (args.in[5])
#define w_qb (args.in[6])
#define norm_kv (args.in[7])
#define w_kvb (args.in[8])
#define rpb (args.in[9])
#define w_br_a (args.in[10])
#define w_br_b (args.in[11])
#define w_o (args.in[12])
#define norm_ffn (args.in[13])
#define w_up (args.in[14])
#define conv_w (args.in[15])
#define conv_b (args.in[16])
#define w_down (args.in[17])
#define norm_final (args.in[18])
#define out (args.out)
#define ROPE_T ((f32x2*)(ws + WS_ROPE))
#define WIN ((bf16_t*)(ws + WS_WIN))
#define WQB ((bf16_t*)(ws + WS_WQB))
#define WKVB ((bf16_t*)(ws + WS_WKVB))
#define WBRA ((bf16_t*)(ws + WS_WBRA))
#define WBRB ((bf16_t*)(ws + WS_WBRB))
#define WO ((bf16_t*)(ws + WS_WO))
#define WUP ((bf16_t*)(ws + WS_WUP))
#define WDN ((bf16_t*)(ws + WS_WDN))
#define XN ((bf16_t*)(ws + WS_XN))
#define KV ((bf16_t*)(ws + WS_KV))
#define CQKV ((bf16_t*)(ws + WS_CQKV))
#define MG ((bf16_t*)(ws + WS_MG))
#define NAQK ((bf16_t*)(ws + WS_NAQK))
#define VT ((bf16_t*)(ws + WS_VT))
#define Qb ((bf16_t*)(ws + WS_Q))
#define OA ((bf16_t*)(ws + WS_OA))
#define OB ((bf16_t*)(ws + WS_OB))
#define MB ((bf16_t*)(ws + WS_MB))
#define KPE ((bf16_t*)(ws + WS_KPE))
#define GB ((bf16_t*)(ws + WS_G))
#define ACT ((bf16_t*)(ws + WS_ACT))
#define GATES ((bf16_t*)out)

    const int lo = args.ph_lo, hi = args.ph_hi;
#define IN(k) (lo <= (k) && (k) < hi)
#define SEAM(k) do { if (IN(k) && IN((k) + 1)) { xcd_barrier(bar); if (PROBE_DUP == 100) xcd_barrier(bar); } } while (0)
    volatile LAS unsigned* MISC = (volatile LAS unsigned*)(lds + RING_BYTES);
    if (threadIdx.x < 64) MISC[threadIdx.x] = 0u;
    __syncthreads();
    XcdBarrier bar; bar.bar = (unsigned*)(ws + WS_CTL); bar.x = 0; bar.st = MISC + 8;
    if (hi - lo > 1) bar = xcd_barrier_post((unsigned*)(ws + WS_CTL), MISC + 8);
    if (lo < 0) cg::this_grid().sync();

    if (IN(0)) {
        OPAQUE_TID();
        LAS float* scr = (LAS float*)(lds + wave * 16384);
        constexpr int I_IN = (DM / 64) * (IN_PAD / 32), I_QB = (QL / 64) * (768 / 32), I_KVB = (KVL / 64) * (1024 / 32), I_BR = (512 / 64) * (1024 / 32),
                      I_O = (DM / 64) * (1024 / 32), I_UP = (DM / 64) * (5632 / 32), I_DN = (DFF / 64) * (1024 / 32);
        constexpr int NITEMS = I_IN + I_QB + I_KVB + 2 * I_BR + I_O + I_UP + I_DN;
        for (int it = gw; it < NITEMS; it += NGW) {
            int r = it;
            if (r < I_IN) { const int nb = r % (IN_PAD / 32), kb = r / (IN_PAD / 32), n0 = nb * 32; const int s0 = n0 < 1024 ? n0 : (n0 < 4608 ? n0 + 32 : (n0 < 4640 ? n0 - 3584 : -1));
                transpose_item(w_in, IN_COLS, WIN, DM, kb * 64, n0, s0, scr, lane); continue; } r -= I_IN;
            if (r < I_QB) { const int nb = r % 24, kb = r / 24, n0 = nb * 32; const int s0 = n0 < 512 ? (n0 >> 6) * 96 + (n0 & 63) : ((n0 - 512) >> 5) * 96 + 64;
                transpose_item(w_qb, 768, WQB, QL, kb * 64, n0, s0, scr, lane); continue; } r -= I_QB;
            if (r < I_KVB) { const int nb = r % 32, kb = r / 32, n0 = nb * 32; const int s0 = n0 < 512 ? (n0 >> 6) * 128 + (n0 & 63) : ((n0 - 512) >> 6) * 128 + 64 + ((n0 - 512) & 63);
                transpose_item(w_kvb, 1024, WKVB, KVL, kb * 64, n0, s0, scr, lane); continue; } r -= I_KVB;
            if (r < I_BR) { const int nb = r % 32, kb = r / 32; transpose_item(w_br_a, 1024, WBRA, 512, kb * 64, nb * 32, nb * 32, scr, lane); continue; } r -= I_BR;
            if (r < I_BR) { const int nb = r % 32, kb = r / 32; transpose_item(w_br_b, 1024, WBRB, 512, kb * 64, nb * 32, nb * 32, scr, lane); continue; } r -= I_BR;
            if (r < I_O) { const int nb = r % 32, kb = r / 32; transpose_item(w_o, 1024, WO, DM, kb * 64, nb * 32, nb * 32, scr, lane); continue; } r -= I_O;
            if (r < I_UP) { const int nb = r % 176, kb = r / 176; transpose_item(w_up, 5632, WUP, DM, kb * 64, nb * 32, nb * 32, scr, lane); continue; } r -= I_UP;
            { const int nb = r % 32, kb = r / 32; transpose_item(w_down, 1024, WDN, DFF, kb * 64, nb * 32, nb * 32, scr, lane); }
        }
        for (int m = gw; m < T; m += NGW) rms_row_bf16(m < TP ? xp + (size_t)m * DM : xs + (size_t)(m - TP) * DM, norm_mix, XN + (size_t)m * DM, lane);
        for (int i = vcu * 512 + tid; i < TS * 16; i += G * 512) { const int s = i >> 4, k = i & 15;
            double inv = 1.0; for (int q = 0; q < k; ++q) inv *= 0.5623413251903491;
            const double ang = (double)s * inv; const double nrev = __builtin_rint(ang * 0.15915494309189535);
            const float red = (float)(ang - nrev * 6.283185307179586);
            ROPE_T[i] = (f32x2){cosf(red), sinf(red)}; }
    }
    SEAM(0);
    if (IN(1)) {
        pg8::Gemm g{XN, WIN, T, IN_PAD, DM, DM, DM}; pg8::StaticOrder S; S.init(T, IN_PAD, G, bx, REPS(1));
        pg8::EpiIn E{CQKV, NAQK, VT, GATES, KPE, b_gate};
        pg8::gemm_phase(lds, g, S, E);
    }
    SEAM(1);
    if (IN(2)) {
        OPAQUE_TID();
        for (int t = gw; t < T; t += NGW) {
            bf16_t* row = CQKV + (size_t)t * 1024;
            u32x2 w[3]; float f[3][4]; float s = 0.f;
#pragma unroll
            for (int j = 0; j < 3; ++j) { w[j] = *(const u32x2*)(row + j * 256 + lane * 4); f[j][0] = bf_lo(w[j].x); f[j][1] = bf_hi(w[j].x); f[j][2] = bf_lo(w[j].y); f[j][3] = bf_hi(w[j].y);
                s += (f[j][0] * f[j][0] + f[j][1] * f[j][1]) + (f[j][2] * f[j][2] + f[j][3] * f[j][3]); }
            const u32x2 wk = *(const u32x2*)(row + 768 + lane * 4); float fk[4] = {bf_lo(wk.x), bf_hi(wk.x), bf_lo(wk.y), bf_hi(wk.y)};
            float sk = (fk[0] * fk[0] + fk[1] * fk[1]) + (fk[2] * fk[2] + fk[3] * fk[3]);
            const float rq = 1.f / sqrtf(wave_sum(s) * (1.f / QL) + EPS), rk = 1.f / sqrtf(wave_sum(sk) * (1.f / KVL) + EPS);
#pragma unroll
            for (int j = 0; j < 3; ++j) { const f32x4 gq = *(const f32x4*)(norm_q + j * 256 + lane * 4); u32x2 o; o.x = cvt_pk_bf16(f[j][0] * rq * gq.x, f[j][1] * rq * gq.y); o.y = cvt_pk_bf16(f[j][2] * rq * gq.z, f[j][3] * rq * gq.w);
                *(u32x2*)(row + j * 256 + lane * 4) = o; }
            { const f32x4 gk = *(const f32x4*)(norm_kv + lane * 4); u32x2 o; o.x = cvt_pk_bf16(fk[0] * rk * gk.x, fk[1] * rk * gk.y); o.y = cvt_pk_bf16(fk[2] * rk * gk.z, fk[3] * rk * gk.w);
                *(u32x2*)(row + 768 + lane * 4) = o; }
            if (lane < 16) { bf16_t* kp = KPE + (size_t)t * 32; const float x1 = __uint_as_float((unsigned)kp[lane] << 16), x2 = __uint_as_float((unsigned)kp[16 + lane] << 16);
                const f32x2 cs = ROPE_T[(size_t)seq_pos(t) * 16 + lane];
                const unsigned o1 = cvt_pk_bf16(x1 * cs.x - x2 * cs.y, 0.f), o2 = cvt_pk_bf16(x1 * cs.y + x2 * cs.x, 0.f);
                kp[lane] = (bf16_t)(o1 & 0xffffu); kp[16 + lane] = (bf16_t)(o2 & 0xffffu); }
        }
        LAS float* rpbl = (LAS float*)lds;
        for (int i = tid; i < 8 * 15 * 31; i += 512) rpbl[i] = rpb[i];
        __syncthreads();
        const int n16 = lane & 15, g4 = lane >> 4;
        constexpr int NA_BUF0 = 16384, NA_BUFSZ = 18432, NA_PITCH = 144;
        for (int rep = 0; rep < REPS(2); ++rep)
        for (int ub = bx; ub < 5120; ub += G) {
            const int hp = ub & 3, rowidx = ub >> 2;
            const int tb = rowidx < 1024 ? (rowidx >> 6) * 4096 : TP, rows = rowidx < 1024 ? 64 : 256, r = rowidx < 1024 ? (rowidx & 63) : rowidx - 1024;
            const int rs = min(max(r - 4, 0), rows - 8);
            const int h = 2 * hp + (wave >> 2), cbk = wave & 3, c0 = cbk * 16;
            const int kc0 = cbk == 0 ? 0 : (cbk == 1 ? 8 : (cbk == 2 ? 24 : 32));
            const int t0 = tb + r * 64 + c0;
            const bf16_t* qp = NAQK + (size_t)(t0 + n16) * 1024 + h * 64 + 8 * g4;
            const bf16x8 aq0 = *(const bf16x8*)qp, aq1 = *(const bf16x8*)(qp + 32);
            const int srow = (tid >> 3) & 63, spart = tid & 7;
            const bf16_t* ksrc0 = NAQK + (size_t)(tb + rs * 64 + srow) * 1024 + 512 + (2 * hp) * 64 + spart * 8;
            const bf16_t* vsrc0 = VT + (size_t)((2 * hp) * 64 + srow) * VTP + tb + rs * 64 + spart * 8;
            const int sdst = srow * NA_PITCH + spart * 16;
            u32x4 st0, st1;
#define NA_LOAD(s_) do { if ((s_) < 8) { st0 = *(const u32x4*)(ksrc0 + (size_t)(s_) * 65536); st1 = *(const u32x4*)(ksrc0 + (size_t)(s_) * 65536 + 64); } \
                         else { st0 = *(const u32x4*)(vsrc0 + ((s_) - 8) * 64); st1 = *(const u32x4*)(vsrc0 + ((s_) - 8) * 64 + (size_t)64 * VTP); } } while (0)
#define NA_WRITE(b_) do { *(LAS u32x4*)(lds + NA_BUF0 + (b_) * NA_BUFSZ + sdst) = st0; *(LAS u32x4*)(lds + NA_BUF0 + (b_) * NA_BUFSZ + 9216 + sdst) = st1; } while (0)
            NA_LOAD(0); NA_WRITE(0);
            __syncthreads();
            f32x4 sc[16]; f32x4 oacc[4]; float linv = 0.f;
#pragma unroll
            for (int nt = 0; nt < 4; ++nt) oacc[nt] = (f32x4){0.f, 0.f, 0.f, 0.f};
            const int hoff = (wave >> 2) * 9216;
#pragma unroll
            for (int s_ = 0; s_ < 16; ++s_) {
                if (s_ + 1 < 16) NA_LOAD(s_ + 1);
                const LAS unsigned char* bufp = lds + NA_BUF0 + (s_ & 1) * NA_BUFSZ + hoff;
                if (s_ < 8) {
#pragma unroll
                    for (int jt = 0; jt < 2; ++jt) { const LAS unsigned char* kp = bufp + (kc0 + jt * 16 + n16) * NA_PITCH + g4 * 16;
                        const bf16x8 k0 = *(const LAS bf16x8*)kp, k1 = *(const LAS bf16x8*)(kp + 64);
                        f32x4 a = {0.f, 0.f, 0.f, 0.f};
                        a = __builtin_amdgcn_mfma_f32_16x16x32_bf16(k0, aq0, a, 0, 0, 0); a = __builtin_amdgcn_mfma_f32_16x16x32_bf16(k1, aq1, a, 0, 0, 0); sc[2 * s_ + jt] = a; }
                } else {
                    const int kk = s_ - 8;
                    u32x4 pw; pw.x = cvt_pk_bf16(sc[2 * kk][0], sc[2 * kk][1]); pw.y = cvt_pk_bf16(sc[2 * kk][2], sc[2 * kk][3]);
                    pw.z = cvt_pk_bf16(sc[2 * kk + 1][0], sc[2 * kk + 1][1]); pw.w = cvt_pk_bf16(sc[2 * kk + 1][2], sc[2 * kk + 1][3]);
                    const bf16x8 pf = __builtin_bit_cast(bf16x8, pw);
#pragma unroll
                    for (int nt = 0; nt < 4; ++nt) { const LAS unsigned char* vp = bufp + (nt * 16 + n16) * NA_PITCH + (kc0 + 4 * g4) * 2;
                        const u32x2 v0 = *(const LAS u32x2*)vp, v1 = *(const LAS u32x2*)(vp + 32);
                        const u32x4 vv = {v0.x, v0.y, v1.x, v1.y};
                        oacc[nt] = __builtin_amdgcn_mfma_f32_16x16x32_bf16(__builtin_bit_cast(bf16x8, vv), pf, oacc[nt], 0, 0, 0); }
                }
                if (s_ == 7) {
                    const int c = c0 + n16, cs = min(max(c - 8, 0), 48);
                    float mx = -1e30f;
#pragma unroll
                    for (int j = 0; j < 16; ++j) { const int kr = j >> 1; const int brow = (h * 15 + (rs + kr - r + 7)) * 31;
#pragma unroll
                        for (int i = 0; i < 4; ++i) { const int kc = kc0 + (j & 1) * 16 + 4 * g4 + i; const bool valid = (kc >= cs) && (kc < cs + 16);
                            const int bi = valid ? (brow + kc - c + 15) : 0;
                            const float sv = valid ? (sc[j][i] * 0.125f + rpbl[bi]) * LOG2E : -1e30f; sc[j][i] = sv; mx = __builtin_fmaxf(mx, sv); } }
                    mx = __builtin_fmaxf(mx, __shfl_xor(mx, 16)); mx = __builtin_fmaxf(mx, __shfl_xor(mx, 32));
                    float sum = 0.f;
#pragma unroll
                    for (int j = 0; j < 16; ++j)
#pragma unroll
                        for (int i = 0; i < 4; ++i) { const float pe = __builtin_amdgcn_exp2f(sc[j][i] - mx); sc[j][i] = pe; sum += pe; }
                    sum += __shfl_xor(sum, 16); sum += __shfl_xor(sum, 32);
                    linv = 1.f / sum;
                }
                if (s_ + 1 < 16) NA_WRITE((s_ + 1) & 1);
                __syncthreads();
            }
            bf16_t* op = OB + (size_t)(t0 + n16) * 512 + h * 64 + 4 * g4;
#pragma unroll
            for (int nt = 0; nt < 4; ++nt) { u32x2 w; w.x = cvt_pk_bf16(oacc[nt][0] * linv, oacc[nt][1] * linv); w.y = cvt_pk_bf16(oacc[nt][2] * linv, oacc[nt][3] * linv); *(u32x2*)(op + nt * 16) = w; }
#undef NA_LOAD
#undef NA_WRITE
        }
        __syncthreads();
    }
    SEAM(2);
    if (IN(3)) {
        { pg8::Gemm g{CQKV, WQB, T, 768, QL, 1024, QL}; pg8::StaticOrder S; S.init(T, 768, G, bx, REPS(3)); pg8::EpiQ E{Qb, ROPE_T, C2_MLA}; pg8::gemm_phase(lds, g, S, E); }
        { pg8::Gemm g{CQKV + 768, WKVB, T, 1024, KVL, 1024, KVL}; pg8::StaticOrder S; S.init(T, 1024, G, bx, REPS(3)); pg8::EpiKV E{KV, KV + (size_t)T * 512}; pg8::gemm_phase(lds, g, S, E); }
        { pg8::Gemm g{OB, WBRB, T, 1024, 512, 512, 512}; pg8::StaticOrder S; S.init(T, 1024, G, bx, REPS(3)); pg8::EpiGateB E{MB, GATES}; pg8::gemm_phase(lds, g, S, E); }
    }
    SEAM(3);
    if (IN(4)) {
        LAS char* shm = (LAS char*)lds;
        if (G == 256) {
            for (int i = 0; i < 8; ++i) { const int bh = (vcu >> 4) + 16 * i, b = bh >> 3, h = bh & 7, qb = vcu & 15; mla::attn_unit<0>(b * 4096, 64, h, qb * 256, Qb, KV, KPE, OA, shm); }
            for (int i = 0; i < 2; ++i) { const int h = vcu >> 5, qb = (vcu & 31) + 32 * i; mla::attn_unit<0>(TP, 256, h, qb * 256, Qb, KV, KPE, OA, shm); }
#if PROBE_DUP >= 40 && PROBE_DUP < 50
            { bf16_t* OAX = (bf16_t*)(ws + 860 * MiB);
            for (int i = 0; i < 8; ++i) { const int bh = (vcu >> 4) + 16 * i, b = bh >> 3, h = bh & 7, qb = vcu & 15; mla::attn_unit<PROBE_DUP - 40>(b * 4096, 64, h, qb * 256, Qb, KV, KPE, OAX, shm); }
            for (int i = 0; i < 2; ++i) { const int h = vcu >> 5, qb = (vcu & 31) + 32 * i; mla::attn_unit<PROBE_DUP - 40>(TP, 256, h, qb * 256, Qb, KV, KPE, OAX, shm); } }
#endif
        } else {
            for (int uix = bx; uix < 2048 + 512; uix += G) {
                if (uix < 2048) { const int bh = uix >> 4, qb = uix & 15; mla::attn_unit<0>((bh >> 3) * 4096, 64, bh & 7, qb * 256, Qb, KV, KPE, OA, shm); }
                else { const int v = uix - 2048; mla::attn_unit<0>(TP, 256, v >> 6, (v & 63) * 256, Qb, KV, KPE, OA, shm); }
            }
        }
    }
    SEAM(4);
    if (IN(5)) { pg8::Gemm g{OA, WBRA, T, 1024, 512, 512, 512}; pg8::StaticOrder S; S.init(T, 1024, G, bx, REPS(5)); pg8::EpiMerge E{MG, GATES, MB}; pg8::gemm_phase(lds, g, S, E); }
    SEAM(5);
    if (IN(6)) { pg8::Gemm g{MG, WO, T, 1024, DM, DM, DM}; pg8::StaticOrder S; S.init(T, 1024, G, bx, REPS(6)); pg8::EpiResid E{xp, xs, out}; pg8::gemm_phase(lds, g, S, E); }
    SEAM(6);
    if (IN(7)) for (int rep = 0; rep < REPS(7); ++rep) { OPAQUE_TID(); for (int m = gw; m < T; m += NGW) rms_row_bf16(out + (size_t)m * DM, norm_ffn, XN + (size_t)m * DM, lane); }
    SEAM(7);
    if (IN(8)) { pg8::Gemm g{XN, WUP + (size_t)DFF * DM, T, FA, DM, DM, DM}; pg8::StaticOrder S; S.init(T, FA, G, bx, REPS(8)); pg8::EpiPlain E{GB, FA, 1.f}; pg8::gemm_phase(lds, g, S, E); }
    SEAM(8);
    if (IN(9)) { pg8::Gemm g{XN, WUP, T, FA, DM, DM, DM}; pg8::StaticOrder S; S.init(T, FA, G, bx, REPS(9)); pg8::EpiConv E{ACT, GB, FA, conv_w, conv_b, 0}; pg8::gemm_phase(lds, g, S, E); }
    SEAM(9);
    if (IN(10)) {
        { pg8::Gemm g{ACT, WDN, T, 1024, FA, FA, DFF}; pg8::StaticOrder S; S.init(T, 1024, G, bx); pg8::EpiResid E{nullptr, nullptr, out}; pg8::gemm_phase(lds, g, S, E); }
    }
    SEAM(10);
    if (IN(11)) { pg8::Gemm g{XN, WUP + (size_t)(DFF + FA) * DM, T, FB, DM, DM, DM}; pg8::StaticOrder S; S.init(T, FB, G, bx); pg8::EpiPlain E{GB, FB, 1.f}; pg8::gemm_phase(lds, g, S, E); }
    SEAM(11);
    if (IN(12)) { pg8::Gemm g{XN, WUP + (size_t)FA * DM, T, FB, DM, DM, DM}; pg8::StaticOrder S; S.init(T, FB, G, bx); pg8::EpiConv E{ACT, GB, FB, conv_w, conv_b, FA}; pg8::gemm_phase(lds, g, S, E); }
    SEAM(12);
    if (IN(13)) {
        { pg8::Gemm g{ACT, WDN + FA, T, 1024, FB, FB, DFF}; pg8::StaticOrder S; S.init(T, 1024, G, bx); pg8::EpiResid E{nullptr, nullptr, out}; pg8::gemm_phase(lds, g, S, E); }
    }
    SEAM(13);
    if (IN(14)) {
        OPAQUE_TID();
        for (int m = gw; m < T; m += NGW) {
            f32x4* xr = (f32x4*)(out + (size_t)m * DM) + lane; const f32x4* gr = (const f32x4*)norm_final + lane;
            f32x4 v[4]; float s = 0.f;
#pragma unroll
            for (int j = 0; j < 4; ++j) { v[j] = xr[64 * j]; s += (v[j].x * v[j].x + v[j].y * v[j].y) + (v[j].z * v[j].z + v[j].w * v[j].w); }
            const float rstd = 1.f / sqrtf(wave_sum(s) * (1.f / DM) + EPS);
#pragma unroll
            for (int j = 0; j < 4; ++j) { const f32x4 g = gr[64 * j]; xr[64 * j] = (f32x4){v[j].x * rstd * g.x, v[j].y * rstd * g.y, v[j].z * rstd * g.z, v[j].w * rstd * g.w}; }
        }
    }
#undef IN
#undef SEAM
#undef ws
#undef xp
#undef xs
#undef norm_mix
#undef w_in
#undef b_gate
#undef norm_q
#undef w_qb
#undef norm_kv
#undef w_kvb
#undef rpb
#undef w_br_a
#undef w_br_b
#undef w_o
#undef norm_ffn
#undef w_up
#undef conv_w
#undef conv_b
#undef w_down
#undef norm_final
#undef out
#undef ROPE_T
#undef WIN
#undef WQB
#undef WKVB
#undef WBRA
#undef WBRB
#undef WO
#undef WUP
#undef WDN
#undef XN
#undef KV
#undef CQKV
#undef MG
#undef NAQK
#undef VT
#undef Qb
#undef OA
#undef OB
#undef MB
#undef KPE
#undef GB
#undef ACT
#undef GATES
}

extern "C" void kernel_launch(void* const* d_in, const int* in_sizes, int n_in, void* d_out, int out_size, void* d_ws, size_t ws_size, hipStream_t stream) {
    static int grid = 0;
    if (grid == 0) {
        if (n_in != 19 || out_size != T * DM || ws_size < WS_END) { fprintf(stderr, "kernel_launch: unexpected shapes (n_in %d, out %d, ws %zu)\n", n_in, out_size, ws_size); grid = -1; return; }
        int dev = 0, cus = 0, per_cu = 0;
        hipGetDevice(&dev); hipDeviceGetAttribute(&cus, hipDeviceAttributeMultiprocessorCount, dev);
        if (hipFuncSetAttribute((const void*)mega_fwd, hipFuncAttributeMaxDynamicSharedMemorySize, LDS_BYTES) != hipSuccess) { fprintf(stderr, "kernel_launch: hipFuncSetAttribute failed\n"); grid = -1; return; }
        if (hipOccupancyMaxActiveBlocksPerMultiprocessor(&per_cu, (const void*)mega_fwd, 512, LDS_BYTES) != hipSuccess || per_cu < 1) { fprintf(stderr, "kernel_launch: occupancy query says %d\n", per_cu); per_cu = 1; }
        (void)hipGetLastError();
        grid = cus * per_cu;
        fprintf(stderr, "kernel_launch: grid %d (cus %d x %d)\n", grid, cus, per_cu);
    }
    if (grid < 0) return;
    if (hipMemsetAsync((char*)d_ws + WS_CTL, 0, 65536, stream) != hipSuccess) { fprintf(stderr, "kernel_launch: memset failed\n"); return; }
    Args a{};
    for (int i = 0; i < 19; ++i) a.in[i] = (const float*)d_in[i];
    a.out = (float*)d_out; a.ws = (unsigned char*)d_ws;
#if MK_N_LAUNCHES == 1
    a.ph_lo = 0; a.ph_hi = NPH + 1;
    void* kargs[] = {&a};
    hipError_t e = hipLaunchCooperativeKernel((const void*)mega_fwd, dim3(grid), dim3(512), kargs, LDS_BYTES, stream);
    if (e != hipSuccess) fprintf(stderr, "cooperative launch failed: %s (grid %d)\n", hipGetErrorString(e), grid);
#else
    for (int p = 0; p <= NPH; ++p) { a.ph_lo = p; a.ph_hi = p + 1; hipLaunchKernelGGL(mega_fwd, dim3(grid), dim3(512), LDS_BYTES, stream, a); }
#endif
}
```
